# Optimizing an MI355X kernel written in HIP

```python
import math
import jax
import jax.numpy as jnp
from jax import lax
import numpy as np

D_MODEL = 1024
BATCH = 16
SEQ = 2048
DEPTH = 2

GRID_W = 64
CTX_LEN = 256
HEAD_DIM = 64
ROPE_THETA = 10000.0
EPS = 1e-6
NEG_INF = -1e30
BLOCK = 128
CONV_WIDTH = 3
A_WIDTH = D_MODEL // 2
B_HEADS = D_MODEL // 256
B_QK_DIM = HEAD_DIM
B_V_DIM = 2 * HEAD_DIM
B_QK_WIDTH = B_HEADS * 2 * B_QK_DIM
B_V_WIDTH = B_HEADS * B_V_DIM
C_HEADS = D_MODEL // 128
C_KV_HEADS = C_HEADS // 4
C_GROUP = C_HEADS // C_KV_HEADS
C_Q_WIDTH = C_HEADS * HEAD_DIM
C_KV_WIDTH = C_KV_HEADS * HEAD_DIM
WINDOW = 128
POOL_SIZES = (2, 4, 8, 16)
D_WIDTH = D_MODEL // 2
POOL_GROUP = D_WIDTH // len(POOL_SIZES)
D_FF = ((8 * D_MODEL // 3 + 127) // 128) * 128
MIX_WIDTH = A_WIDTH + B_V_WIDTH
AB_COLS = 3 * A_WIDTH + 2 * B_QK_WIDTH + B_V_WIDTH
CD_COLS = C_Q_WIDTH + 2 * C_KV_WIDTH + D_WIDTH
N_EVEN = (DEPTH + 1) // 2
N_ODD = DEPTH // 2

kernel_name = 'hybrid_flow_backbone_block'


def rms_norm(x, w=None):
    xf = x.astype(jnp.float32)
    y = xf * lax.rsqrt(jnp.mean(xf * xf, axis=-1, keepdims=True) + EPS)
    if w is not None:
        y = y * w.astype(jnp.float32)
    return y.astype(x.dtype)


def modulate(xn, shift, scale):
    return xn * (1.0 + scale) + shift


def ada_mods(cvec, w, b):
    return jnp.split(jax.nn.silu(cvec) @ w + b, 6, axis=-1)


def lambda_init(layer):
    return 0.8 - 0.6 * math.exp(-0.3 * layer)


def dwconv3(x, w):
    xp = jnp.pad(x, ((0, 0), (1, 1), (0, 0)))
    return xp[:, :-2] * w[0] + xp[:, 1:-1] * w[1] + xp[:, 2:] * w[2]


def axial_rope_angles(n):
    rows = n // GRID_W
    row = jnp.repeat(jnp.arange(rows, dtype=jnp.int32), GRID_W)
    col = jnp.tile(jnp.arange(GRID_W, dtype=jnp.int32), rows)
    axis_dim = HEAD_DIM // 2
    inv = 1.0 / (ROPE_THETA ** (jnp.arange(0, axis_dim, 2, dtype=jnp.float32) / axis_dim))
    return row.astype(jnp.float32)[:, None] * inv, col.astype(jnp.float32)[:, None] * inv


def rope_1d(x, ang):
    x1, x2 = jnp.split(x, 2, axis=-1)
    cos = jnp.cos(ang).astype(x.dtype)
    sin = jnp.sin(ang).astype(x.dtype)
    return jnp.concatenate([x1 * cos - x2 * sin, x1 * sin + x2 * cos], axis=-1)


def apply_axial_rope(x, ang_row, ang_col):
    shape = (x.shape[1],) + (1,) * (x.ndim - 3) + (ang_row.shape[-1],)
    xr, xc = jnp.split(x, 2, axis=-1)
    return jnp.concatenate([rope_1d(xr, ang_row.reshape(shape)), rope_1d(xc, ang_col.reshape(shape))], axis=-1)


def diff_attend(q, k, v, lam):
    s = jnp.einsum('bqhmd,bkhmd->bhmqk', q, k).astype(jnp.float32) * (B_QK_DIM ** -0.5)
    p = jax.nn.softmax(s, axis=-1)
    w = (p[:, :, 0] - lam * p[:, :, 1]).astype(v.dtype)
    return jnp.einsum('bhqk,bkhe->bqhe', w, v)


def sink_attend(q, ks, vs, masks, sink):
    b, nq = q.shape[0], q.shape[1]
    logits = [jnp.broadcast_to(sink[None, :, :, None, None], (b, C_KV_HEADS, C_GROUP, nq, 1))]
    for k, m in zip(ks, masks):
        s = jnp.einsum('bqhgd,bkhd->bhgqk', q, k).astype(jnp.float32)
        if m is not None:
            s = jnp.where(m, s, NEG_INF)
        logits.append(s)
    p = jax.nn.softmax(jnp.concatenate(logits, axis=-1), axis=-1)
    terms = []
    start = 1
    for k, v in zip(ks, vs):
        pk = lax.slice_in_dim(p, start, start + k.shape[1], axis=-1).astype(v.dtype)
        terms.append(jnp.einsum('bhgqk,bkhd->bqhgd', pk, v))
        start += k.shape[1]
    return sum(terms)


def multiscale_pool(p, w_pool, scale):
    b, n, _ = p.shape
    pf = p.astype(jnp.float32)
    cs = jnp.concatenate([jnp.zeros((b, 1, D_WIDTH), jnp.float32), jnp.cumsum(pf, axis=1)], axis=1)
    t = jnp.arange(n, dtype=jnp.int32)
    outs = []
    for g, w in enumerate(POOL_SIZES):
        lo = jnp.clip(t - w // 2, 0, n)
        hi = jnp.clip(t + w // 2, 0, n)
        sl = slice(g * POOL_GROUP, (g + 1) * POOL_GROUP)
        csg = cs[:, :, sl]
        mean = (csg[:, hi] - csg[:, lo]) / (hi - lo).astype(jnp.float32)[:, None]
        outs.append(mean - pf[:, :, sl])
    z = jnp.stack(outs, axis=2).astype(p.dtype)
    z = jnp.einsum('bngc,gce->bnge', z, w_pool).reshape(b, n, D_WIDTH)
    return z * scale


def conv_ffn(h, w_up, conv_w, conv_b, w_down):
    u = dwconv3(h @ w_up, conv_w) + conv_b
    a, g = jnp.split(u, 2, axis=-1)
    return (jax.nn.silu(g) * a) @ w_down


def mixer_ab(hl, hc, w_in, conv_w, lam_qk, subln_w, w_out, lam_init, ang_row, ang_col, ctx_out):
    b, n, _ = hl.shape
    lc = hc.shape[1]
    splits = [A_WIDTH, 2 * A_WIDTH, 3 * A_WIDTH, 3 * A_WIDTH + B_QK_WIDTH, 3 * A_WIDTH + 2 * B_QK_WIDTH]
    gb, gc, hv, q, k, v = jnp.split(hl @ w_in, splits, axis=-1)
    gbc, gcc, hvc, qc, kc, vc = jnp.split(hc @ w_in, splits, axis=-1)
    lq = lam_qk.astype(jnp.float32)
    lam = jnp.exp(jnp.sum(lq[0] * lq[1])) - jnp.exp(jnp.sum(lq[2] * lq[3])) + lam_init
    ql = apply_axial_rope(q.reshape(b, n, B_HEADS, 2, B_QK_DIM), ang_row, ang_col)
    kl = apply_axial_rope(k.reshape(b, n, B_HEADS, 2, B_QK_DIM), ang_row, ang_col)
    vl = v.reshape(b, n, B_HEADS, B_V_DIM)
    kcx = kc.reshape(b, lc, B_HEADS, 2, B_QK_DIM)
    vcx = vc.reshape(b, lc, B_HEADS, B_V_DIM)
    k_all = jnp.concatenate([kcx, kl], axis=1)
    v_all = jnp.concatenate([vcx, vl], axis=1)
    nb = n // BLOCK
    qb = ql.reshape(b, nb, BLOCK, B_HEADS, 2, B_QK_DIM).swapaxes(0, 1)
    ob = lax.map(lambda qi: diff_attend(qi, k_all, v_all, lam), qb)
    yb = ob.swapaxes(0, 1).reshape(b, n, B_HEADS, B_V_DIM)
    yb = (rms_norm(yb, subln_w) * (1.0 - lam_init)).reshape(b, n, B_V_WIDTH)
    ya = gb * dwconv3(gc * hv, conv_w)
    yl = jnp.concatenate([ya, yb], axis=-1) @ w_out
    yc = None
    if ctx_out:
        ybc = diff_attend(qc.reshape(b, lc, B_HEADS, 2, B_QK_DIM), kcx, vcx, lam)
        ybc = (rms_norm(ybc, subln_w) * (1.0 - lam_init)).reshape(b, lc, B_V_WIDTH)
        yac = gbc * dwconv3(gcc * hvc, conv_w)
        yc = jnp.concatenate([yac, ybc], axis=-1) @ w_out
    return yl, yc


def mixer_cd(hl, hc, w_in, sink, pool_w, pool_scale, w_out, ang_row, ang_col, ctx_out):
    b, n, _ = hl.shape
    lc = hc.shape[1]
    splits = [C_Q_WIDTH, C_Q_WIDTH + C_KV_WIDTH, C_Q_WIDTH + 2 * C_KV_WIDTH]
    q, k, v, pl = jnp.split(hl @ w_in, splits, axis=-1)
    qc, kc, vc, pc = jnp.split(hc @ w_in, splits, axis=-1)
    scale = HEAD_DIM ** -0.5
    sink = sink.astype(jnp.float32).reshape(C_KV_HEADS, C_GROUP)
    ql = apply_axial_rope(q.reshape(b, n, C_KV_HEADS, C_GROUP, HEAD_DIM), ang_row, ang_col) * scale
    kl = apply_axial_rope(k.reshape(b, n, C_KV_HEADS, HEAD_DIM), ang_row, ang_col)
    vl = v.reshape(b, n, C_KV_HEADS, HEAD_DIM)
    kcx = kc.reshape(b, lc, C_KV_HEADS, HEAD_DIM)
    vcx = vc.reshape(b, lc, C_KV_HEADS, HEAD_DIM)
    pad = ((0, 0), (WINDOW, WINDOW), (0, 0), (0, 0))
    k_pad = jnp.pad(kl, pad)
    v_pad = jnp.pad(vl, pad)
    band = BLOCK + 2 * WINDOW
    nb = n // BLOCK
    qb = ql.reshape(b, nb, BLOCK, C_KV_HEADS, C_GROUP, HEAD_DIM).swapaxes(0, 1)

    def block(args):
        i, qi = args
        kb = lax.dynamic_slice_in_dim(k_pad, i * BLOCK, band, axis=1)
        vb = lax.dynamic_slice_in_dim(v_pad, i * BLOCK, band, axis=1)
        qpos = i * BLOCK + jnp.arange(BLOCK, dtype=jnp.int32)
        kpos = i * BLOCK - WINDOW + jnp.arange(band, dtype=jnp.int32)
        mask = (jnp.abs(kpos[None, :] - qpos[:, None]) <= WINDOW) & ((kpos >= 0) & (kpos < n))[None, :]
        return sink_attend(qi, [kcx, kb], [vcx, vb], [None, mask], sink)

    ob = lax.map(block, (jnp.arange(nb, dtype=jnp.int32), qb))
    ya = ob.swapaxes(0, 1).reshape(b, n, C_Q_WIDTH)
    yd = multiscale_pool(pl, pool_w, pool_scale)
    yl = jnp.concatenate([ya, yd], axis=-1) @ w_out
    yc = None
    if ctx_out:
        qcx = qc.reshape(b, lc, C_KV_HEADS, C_GROUP, HEAD_DIM) * scale
        yac = sink_attend(qcx, [kcx], [vcx], [None], sink).reshape(b, lc, C_Q_WIDTH)
        ydc = multiscale_pool(pc, pool_w, pool_scale)
        yc = jnp.concatenate([yac, ydc], axis=-1) @ w_out
    return yl, yc


def setup_inputs(seed: int = 0) -> dict:
    key = jax.random.key(seed)
    ks = jax.random.split(key, 24)

    def nrm(k, shape, s):
        return jax.random.normal(k, shape, jnp.float32) * s

    D = D_MODEL
    return {
        'x': nrm(ks[0], (BATCH, SEQ, D), 1.0),
        'c': nrm(ks[1], (BATCH, D), 1.0),
        'ctx': nrm(ks[2], (BATCH, CTX_LEN, D), 1.0),
        'c_ctx': nrm(ks[3], (D,), 1.0),
        'w_mod': nrm(ks[4], (DEPTH, D, 6 * D), 0.5 * D ** -0.5),
        'b_mod': nrm(ks[5], (DEPTH, 6 * D), 0.01),
        'w_in_ab': nrm(ks[6], (N_EVEN, D, AB_COLS), D ** -0.5),
        'conv_a': nrm(ks[7], (N_EVEN, CONV_WIDTH, A_WIDTH), CONV_WIDTH ** -0.5),
        'lam_qk': nrm(ks[8], (N_EVEN, 4, B_QK_DIM), 0.1),
        'subln_b': 1.0 + nrm(ks[9], (N_EVEN, B_V_DIM), 0.02),
        'w_out_ab': nrm(ks[10], (N_EVEN, MIX_WIDTH, D), MIX_WIDTH ** -0.5),
        'w_in_cd': nrm(ks[11], (N_ODD, D, CD_COLS), D ** -0.5),
        'sink_c': nrm(ks[12], (N_ODD, C_HEADS), 0.5),
        'pool_w': nrm(ks[13], (N_ODD, len(POOL_SIZES), POOL_GROUP, POOL_GROUP), POOL_GROUP ** -0.5),
        'pool_scale': 1.0 + nrm(ks[14], (N_ODD, D_WIDTH), 0.1),
        'w_out_cd': nrm(ks[15], (N_ODD, MIX_WIDTH, D), MIX_WIDTH ** -0.5),
        'w_up': nrm(ks[16], (DEPTH, D, 2 * D_FF), D ** -0.5),
        'conv_ffn_w': nrm(ks[17], (DEPTH, CONV_WIDTH, 2 * D_FF), CONV_WIDTH ** -0.5),
        'conv_ffn_b': nrm(ks[18], (DEPTH, 2 * D_FF), 0.01),
        'w_down': nrm(ks[19], (DEPTH, D_FF, D), D_FF ** -0.5),
        'final_norm_w': 1.0 + nrm(ks[20], (D,), 0.02),
    }


def reference(x, c, ctx, c_ctx, w_mod, b_mod, w_in_ab, conv_a, lam_qk, subln_b, w_out_ab, w_in_cd, sink_c, pool_w, pool_scale, w_out_cd, w_up, conv_ffn_w, conv_ffn_b, w_down, final_norm_w):
    ang_row, ang_col = axial_rope_angles(x.shape[1])
    xl, xc = x, ctx
    for l in range(DEPTH):
        ctx_out = l < DEPTH - 1
        ml = [m[:, None, :] for m in ada_mods(c, w_mod[l], b_mod[l])]
        mc = ada_mods(c_ctx, w_mod[l], b_mod[l])
        hl = modulate(rms_norm(xl), ml[0], ml[1])
        hc = modulate(rms_norm(xc), mc[0], mc[1])
        if l % 2 == 0:
            e = l // 2
            yl, yc = mixer_ab(hl, hc, w_in_ab[e], conv_a[e], lam_qk[e], subln_b[e], w_out_ab[e], lambda_init(l), ang_row, ang_col, ctx_out)
        else:
            o = l // 2
            yl, yc = mixer_cd(hl, hc, w_in_cd[o], sink_c[o], pool_w[o], pool_scale[o], w_out_cd[o], ang_row, ang_col, ctx_out)
        xl = xl + ml[2] * yl
        ffn = (w_up[l], conv_ffn_w[l], conv_ffn_b[l], w_down[l])
        xl = xl + ml[5] * conv_ffn(modulate(rms_norm(xl), ml[3], ml[4]), *ffn)
        if ctx_out:
            xc = xc + mc[2] * yc
            xc = xc + mc[5] * conv_ffn(modulate(rms_norm(xc), mc[3], mc[4]), *ffn)
    return rms_norm(xl, final_norm_w)
```

```cpp
#include <hip/hip_runtime.h>
#include <hip/hip_bf16.h>
#include <cstdio>
#include <cstdint>

#ifndef ONE_LAUNCH
#define ONE_LAUNCH 1
#endif

#define LAS __attribute__((address_space(3)))
#define GAS __attribute__((address_space(1)))
typedef unsigned short bf16_t;
typedef short bf16x8 __attribute__((ext_vector_type(8)));
typedef short s16x4 __attribute__((ext_vector_type(4)));
typedef float f32x4 __attribute__((ext_vector_type(4)));
typedef float f32x16 __attribute__((ext_vector_type(16)));
typedef unsigned u32x4 __attribute__((ext_vector_type(4)));
typedef unsigned u32x2 __attribute__((ext_vector_type(2)));

constexpr int DM = 1024, NB = 16, SEQ = 2048, CTXL = 256;
constexpr int ML = NB * SEQ, MC = NB * CTXL, MT = ML + MC;
constexpr int DFF = 2816, NUP = 2 * DFF, NAB = 3072, NCD = 1280;
constexpr float EPS = 1e-6f;
constexpr int NWAVES = 8;
constexpr int CH_ROWS = 4096;

constexpr size_t MiB = 1u << 20;
constexpr size_t WS_CTL = 0, CTL_ZERO_BYTES = 1 * MiB;
constexpr size_t WS_MODS = 1 * MiB;
constexpr size_t WS_BUP0 = 2 * MiB;
constexpr size_t WS_BUP1 = 2 * MiB + 512 * 1024;
constexpr size_t WS_BCD = 3 * MiB;
constexpr size_t WS_ROPEC = 3 * MiB + 256 * 1024;
constexpr size_t WS_ROPES = WS_ROPEC + 4096;
constexpr size_t WS_LAM = 3 * MiB + 512 * 1024;
constexpr size_t WS_WAB = 4 * MiB, WS_WOAB = 10 * MiB, WS_WCD = 12 * MiB, WS_WOCD = 15 * MiB, WS_WUP0 = 17 * MiB, WS_WUP1 = 28 * MiB, WS_WDN0 = 39 * MiB, WS_WDN1 = 45 * MiB;
constexpr size_t WS_XC = 51 * MiB;
constexpr size_t WS_SSQA = 67 * MiB, WS_SSQB = 70 * MiB;
constexpr size_t WS_A1 = 73 * MiB, WS_A2 = 145 * MiB;
constexpr size_t WS_R = 217 * MiB;
constexpr size_t WS_GB = WS_R, WS_P = WS_R + 36 * MiB, WS_Q = WS_R + 72 * MiB, WS_K = WS_R + 108 * MiB, WS_V = WS_R + 144 * MiB;
constexpr size_t WS_ACT = WS_R;
constexpr size_t WS_Q2 = WS_R, WS_PL = WS_R + 36 * MiB, WS_K2 = WS_R + 72 * MiB, WS_V2 = WS_R + 81 * MiB;
constexpr size_t WS_U = 415 * MiB;
constexpr size_t WS_END = 459 * MiB;
constexpr int CW_BAR = 4096;

__device__ __forceinline__ unsigned cvt_pk_bf16(float lo, float hi) { unsigned r; asm volatile("v_cvt_pk_bf16_f32 %0, %1, %2" : "=v"(r) : "v"(lo), "v"(hi)); return r; }
__device__ __forceinline__ u32x4 pack8(f32x4 a, f32x4 b) { u32x4 w; w.x = cvt_pk_bf16(a[0], a[1]); w.y = cvt_pk_bf16(a[2], a[3]); w.z = cvt_pk_bf16(b[0], b[1]); w.w = cvt_pk_bf16(b[2], b[3]); return w; }
__device__ __forceinline__ unsigned f2bf(float f) { unsigned u = __builtin_bit_cast(unsigned, f); return (u + 0x7fffu + ((u >> 16) & 1u)) >> 16; }
__device__ __forceinline__ float bflo(unsigned w) { return __builtin_bit_cast(float, w << 16); }
__device__ __forceinline__ float bfhi(unsigned w) { return __builtin_bit_cast(float, w & 0xffff0000u); }
__device__ __forceinline__ void unpack8(u32x4 w, float (&f)[8]) { f[0] = bflo(w.x); f[1] = bfhi(w.x); f[2] = bflo(w.y); f[3] = bfhi(w.y); f[4] = bflo(w.z); f[5] = bfhi(w.z); f[6] = bflo(w.w); f[7] = bfhi(w.w); }
__device__ __forceinline__ float wave_sum(float v) {
#pragma unroll
    for (int o = 1; o < 64; o <<= 1) v += __shfl_xor(v, o);
    return v;
}

namespace pg8 {
#define PG8_LAS __attribute__((address_space(3)))
constexpr int BM = 256, BK = 64, HALF = 128, HTB = HALF * BK * 2, STAGE_BYTES = 8 * HTB, NXCD = 8, WGM = 8;
__host__ __device__ __forceinline__ int lds_byte(int r, int c) { const int st = (r >> 4) * 2 + (c >> 5), rr = r & 15, cc = c & 31, ob = rr * 64 + cc * 2; return st * 1024 + (ob ^ (((ob >> 9) & 1) << 5)); }
__host__ __device__ __forceinline__ void stage_rc(int b, int& R, int& C) { const int st = b / 1024, sb = b % 1024, swz = sb ^ (((sb >> 9) & 1) << 5); R = (st >> 1) * 16 + swz / 64; C = (st & 1) * 32 + (swz % 64) / 2; }
__host__ __device__ __forceinline__ int perm32(int rho) { const int n = rho >> 4, i = rho & 15; return 8 * (i >> 2) + 4 * n + (i & 3); }
struct Unit { int pm, pn; };
struct Gemm { const bf16_t* A; const bf16_t* Bt; int M, N, K; };
struct StaticOrder {
    int nM, nN, nwg, G, c;
    __host__ __device__ void init(int M, int N, int G_, int c_) { nM = M / BM; nN = N / BM; nwg = nM * nN; G = G_; c = c_; }
    __host__ __device__ bool next(int i, Unit& u) const {
        const long L = (long)i * G + c; if (L >= nwg) return false;
        int wgid = (int)L; { const int q = nwg / NXCD, r = nwg % NXCD, xcd = wgid % NXCD, off = wgid / NXCD; wgid = (xcd < r ? xcd * (q + 1) : r * (q + 1) + (xcd - r) * q) + off; }
        const int nig = WGM * nN, gid = wgid / nig, fm = gid * WGM, gsz = (nM - fm) < WGM ? (nM - fm) : WGM;
        u.pm = fm + ((wgid % nig) % gsz); u.pn = (wgid % nig) / gsz; return true;
    }
    __device__ __forceinline__ void a_ready(const Unit&) const {}
    __device__ __forceinline__ void done(const Unit&) const {}
};
template <class Epi, class Sched, bool ALIGN_EPI = false, bool SP2 = false>
__device__ __forceinline__ void gemm_phase(PG8_LAS unsigned char* lds, const Gemm g, const Sched& S, const Epi& E, const int tid) {
    const int wid = __builtin_amdgcn_readfirstlane(tid >> 6), lane = tid & 63, wr = wid >> 2, wc = wid & 3, fr = lane & 15, fq = lane >> 4;
    const int K = g.K, nt = K / BK;
    unsigned voffA[2], voffB[2];
#pragma unroll
    for (int i = 0; i < 2; ++i) { int R, C; stage_rc(tid * 16 + i * 8192, R, C); const int Rb = Epi::PERM ? ((R & ~31) + perm32(R & 31)) : R;
        voffA[i] = (unsigned)(R * K + C) * 2u; voffB[i] = (unsigned)(Rb * K + C) * 2u; }
    const size_t kstep = (size_t)(BK * 2);
    const size_t hstep = (size_t)HALF * K * 2;
    const size_t tstep = 2 * hstep;
    const unsigned ldsw = (unsigned)wid * 1024u;
    const int aoff = lds_byte(wr * 64 + fr, fq * 8), boff = lds_byte(wc * 32 + fr, fq * 8);
#define PG8_SA(b, h) (((b) * 2 + (h)) * HTB)
#define PG8_SB(b, h) ((4 + (b) * 2 + (h)) * HTB)
#define PG8_STAGE(bufoff, gbase, voff) do { _Pragma("unroll") for (int _i = 0; _i < 2; ++_i) \
        __builtin_amdgcn_global_load_lds((const unsigned*)((const char*)(gbase) + (voff)[_i]), (PG8_LAS unsigned*)(lds + (bufoff) + ldsw + _i * 8192), 16, 0, 0); } while (0)
#define PG8_LDA(dst, b, h) do { _Pragma("unroll") for (int m = 0; m < 4; ++m) _Pragma("unroll") for (int k = 0; k < 2; ++k) dst[m][k] = *(const PG8_LAS bf16x8*)(lds + PG8_SA(b, h) + aoff + m * 2048 + k * 1024); } while (0)
#define PG8_LDB(dst, b, h) do { _Pragma("unroll") for (int n = 0; n < 2; ++n) _Pragma("unroll") for (int k = 0; k < 2; ++k) dst[n][k] = *(const PG8_LAS bf16x8*)(lds + PG8_SB(b, h) + boff + n * 2048 + k * 1024); } while (0)
#define PG8_MMA(ai, bj, At, Bt) do { __builtin_amdgcn_s_setprio(1); _Pragma("unroll") for (int m = 0; m < 4; ++m) _Pragma("unroll") for (int n = 0; n < 2; ++n) _Pragma("unroll") for (int k = 0; k < 2; ++k) \
        acc[ai][bj][m][n] = __builtin_amdgcn_mfma_f32_16x16x32_bf16(Bt[n][k], At[m][k], acc[ai][bj][m][n], 0, 0, 0); __builtin_amdgcn_s_setprio(0); } while (0)
#define PG8_WAIT_V(n) asm volatile("s_waitcnt vmcnt(" #n ")" ::: "memory")
#define PG8_WAIT_L(n) asm volatile("s_waitcnt lgkmcnt(" #n ")" ::: "memory")
#define PG8_BAR __builtin_amdgcn_s_barrier()
#define PG8_SCHED __builtin_amdgcn_sched_barrier(0)
    Unit cur, nxt; int ui = 0;
    if (!S.next(0, cur)) return;
    f32x4 acc[2][2][4][2];
#pragma unroll
    for (int a = 0; a < 2; ++a)
#pragma unroll
        for (int b = 0; b < 2; ++b)
#pragma unroll
            for (int m = 0; m < 4; ++m)
#pragma unroll
                for (int n = 0; n < 2; ++n) acc[a][b][m][n] = (f32x4){0.f, 0.f, 0.f, 0.f};
    bf16x8 At[4][2], B0[2][2], B1[2][2];
    const char* cA = (const char*)g.A + (size_t)cur.pm * tstep; const char* cB = (const char*)g.Bt + (size_t)cur.pn * tstep;
    S.a_ready(cur);
    if constexpr (SP2) {
        PG8_STAGE(PG8_SB(0, 0), cB, voffB); PG8_STAGE(PG8_SB(0, 1), cB + hstep, voffB); PG8_STAGE(PG8_SA(0, 0), cA, voffA); PG8_STAGE(PG8_SA(0, 1), cA + hstep, voffA);
        if (wr == 1) PG8_BAR;
        PG8_WAIT_V(2); PG8_BAR;
        PG8_STAGE(PG8_SB(1, 0), cB + kstep, voffB); PG8_STAGE(PG8_SA(1, 0), cA + kstep, voffA); PG8_STAGE(PG8_SB(1, 1), cB + hstep + kstep, voffB);
        PG8_WAIT_V(6); PG8_BAR;
    } else {
        PG8_STAGE(PG8_SB(0, 0), cB, voffB); PG8_STAGE(PG8_SA(0, 0), cA, voffA); PG8_STAGE(PG8_SB(0, 1), cB + hstep, voffB); PG8_STAGE(PG8_SA(0, 1), cA + hstep, voffA);
        if (wr == 1) PG8_BAR;
        PG8_WAIT_V(4); PG8_BAR;
        PG8_STAGE(PG8_SB(1, 0), cB + kstep, voffB); PG8_STAGE(PG8_SA(1, 0), cA + kstep, voffA); PG8_STAGE(PG8_SB(1, 1), cB + hstep + kstep, voffB);
        PG8_WAIT_V(6); PG8_BAR;
    }
    for (;;) {
        const bool has_next = S.next(ui + 1, nxt);
        const char* nA = has_next ? (const char*)g.A + (size_t)nxt.pm * tstep : cA; const char* nB = has_next ? (const char*)g.Bt + (size_t)nxt.pn * tstep : cB;
        for (int t = 0; t < nt; t += 2) {
            const bool last = (t == nt - 2);
            const char* a1 = cA + (size_t)(t + 1) * kstep;
            const char* a2 = last ? nA : cA + (size_t)(t + 2) * kstep; const char* b2 = last ? nB : cB + (size_t)(t + 2) * kstep;
            const char* a3 = a2 + kstep; const char* b3 = b2 + kstep;
            if (last && has_next) S.a_ready(nxt);
            if constexpr (SP2) {
            PG8_LDB(B0, 0, 0); PG8_LDB(B1, 0, 1); PG8_SCHED; PG8_LDA(At, 0, 0); PG8_STAGE(PG8_SA(1, 1), a1 + hstep, voffA);
            PG8_WAIT_V(8); PG8_WAIT_L(0); PG8_BAR; PG8_MMA(0, 0, At, B0); PG8_MMA(0, 1, At, B1); PG8_BAR; PG8_SCHED;
            PG8_LDA(At, 0, 1); PG8_STAGE(PG8_SB(0, 0), b2, voffB); PG8_STAGE(PG8_SB(0, 1), b2 + hstep, voffB); PG8_STAGE(PG8_SA(0, 0), a2, voffA);
            PG8_WAIT_V(8); PG8_WAIT_L(0); PG8_BAR; PG8_MMA(1, 0, At, B0); PG8_MMA(1, 1, At, B1); PG8_BAR; PG8_SCHED;
            PG8_LDB(B0, 1, 0); PG8_LDB(B1, 1, 1); PG8_SCHED; PG8_LDA(At, 1, 0); PG8_STAGE(PG8_SA(0, 1), a2 + hstep, voffA);
            PG8_WAIT_V(8); PG8_WAIT_L(0); PG8_BAR; PG8_MMA(0, 0, At, B0); PG8_MMA(0, 1, At, B1); PG8_BAR; PG8_SCHED;
            PG8_LDA(At, 1, 1); PG8_STAGE(PG8_SB(1, 0), b3, voffB); PG8_STAGE(PG8_SB(1, 1), b3 + hstep, voffB); PG8_STAGE(PG8_SA(1, 0), a3, voffA);
            PG8_WAIT_V(8); PG8_WAIT_L(0); PG8_BAR; PG8_MMA(1, 0, At, B0); PG8_MMA(1, 1, At, B1); PG8_BAR; PG8_SCHED;
            } else {
            PG8_LDB(B0, 0, 0); PG8_SCHED; PG8_LDA(At, 0, 0); PG8_STAGE(PG8_SA(1, 1), a1 + hstep, voffA);
            PG8_WAIT_L(8); PG8_BAR; PG8_WAIT_L(0); PG8_MMA(0, 0, At, B0); PG8_BAR; PG8_SCHED;
            PG8_LDB(B1, 0, 1); PG8_STAGE(PG8_SB(0, 0), b2, voffB);
            PG8_BAR; PG8_WAIT_L(0); PG8_MMA(0, 1, At, B1); PG8_BAR;
            PG8_LDA(At, 0, 1); PG8_STAGE(PG8_SA(0, 0), a2, voffA);
            PG8_BAR; PG8_WAIT_L(0); PG8_MMA(1, 0, At, B0); PG8_BAR; PG8_SCHED;
            PG8_STAGE(PG8_SB(0, 1), b2 + hstep, voffB);
            PG8_WAIT_V(6); PG8_BAR; PG8_MMA(1, 1, At, B1); PG8_BAR;
            PG8_LDB(B0, 1, 0); PG8_SCHED; PG8_LDA(At, 1, 0); PG8_STAGE(PG8_SA(0, 1), a2 + hstep, voffA);
            PG8_WAIT_L(8); PG8_BAR; PG8_WAIT_L(0); PG8_MMA(0, 0, At, B0); PG8_BAR; PG8_SCHED;
            PG8_LDB(B1, 1, 1); PG8_STAGE(PG8_SB(1, 0), b3, voffB);
            PG8_BAR; PG8_WAIT_L(0); PG8_MMA(0, 1, At, B1); PG8_BAR;
            PG8_LDA(At, 1, 1); PG8_STAGE(PG8_SA(1, 0), a3, voffA);
            PG8_BAR; PG8_WAIT_L(0); PG8_MMA(1, 0, At, B0); PG8_BAR; PG8_SCHED;
            PG8_STAGE(PG8_SB(1, 1), b3 + hstep, voffB);
            PG8_WAIT_V(6); PG8_BAR; PG8_MMA(1, 1, At, B1); PG8_BAR;
            }
        }
        if constexpr (ALIGN_EPI) { if (wr == 0) PG8_BAR; }
        E(acc, cur, wr, wc, fr, fq); S.done(cur);
        if (!has_next) break;
#pragma unroll
        for (int a = 0; a < 2; ++a)
#pragma unroll
            for (int b = 0; b < 2; ++b)
#pragma unroll
                for (int m = 0; m < 4; ++m)
#pragma unroll
                    for (int n = 0; n < 2; ++n) acc[a][b][m][n] = (f32x4){0.f, 0.f, 0.f, 0.f};
        cur = nxt; cA = nA; cB = nB; ++ui;
        if constexpr (ALIGN_EPI) { if (wr == 1) PG8_BAR; }
    }
    PG8_WAIT_V(0);
    if constexpr (!ALIGN_EPI) { if (wr == 0) PG8_BAR; }
    PG8_BAR;
#undef PG8_SA
#undef PG8_SB
#undef PG8_STAGE
#undef PG8_LDA
#undef PG8_LDB
#undef PG8_MMA
#undef PG8_WAIT_V
#undef PG8_WAIT_L
#undef PG8_BAR
#undef PG8_SCHED
}

typedef const f32x4 (&AccRef)[2][2][4][2];

struct EpiAB {
    static constexpr bool PERM = true;
    bf16_t *GB, *P, *Q, *K, *V; const float *ropec, *ropes;
    __device__ __forceinline__ void operator()(AccRef acc, const Unit& u, int wr, int wc, int fr, int fq) const {
        const int pn = u.pn, rb = u.pm * BM + wr * 64 + fr, cl = wc * 32 + 8 * fq;
        if (pn < 4) {
#pragma unroll
            for (int ai = 0; ai < 2; ++ai)
#pragma unroll
                for (int m = 0; m < 4; ++m) { const size_t r = (size_t)(rb + ai * HALF + m * 16);
                    *(u32x4*)(P + r * 512 + pn * 128 + cl) = pack8(acc[ai][0][m][0] * acc[ai][1][m][0], acc[ai][0][m][1] * acc[ai][1][m][1]); }
        } else if (pn < 6) {
#pragma unroll
            for (int ai = 0; ai < 2; ++ai)
#pragma unroll
                for (int m = 0; m < 4; ++m) { const size_t r = (size_t)(rb + ai * HALF + m * 16);
#pragma unroll
                    for (int bj = 0; bj < 2; ++bj) *(u32x4*)(GB + r * 512 + (pn - 4) * 256 + bj * HALF + cl) = pack8(acc[ai][bj][m][0], acc[ai][bj][m][1]); }
        } else if (pn < 10) {
            bf16_t* dst = pn < 8 ? Q : K; const int hm = 4 * ((pn - 6) & 1) + wc, half = fq >> 1, i0 = 8 * (fq & 1);
            const bool latent = u.pm < ML / BM;
#pragma unroll
            for (int ai = 0; ai < 2; ++ai)
#pragma unroll
                for (int m = 0; m < 4; ++m) { const int r = rb + ai * HALF + m * 16;
                    f32x4 c0 = (f32x4){1.f, 1.f, 1.f, 1.f}, c1 = c0, s0 = (f32x4){0.f, 0.f, 0.f, 0.f}, s1 = s0;
                    if (latent) { const int tpos = r & (SEQ - 1), pos = half ? (tpos & 63) : (tpos >> 6);
                        c0 = *(const f32x4*)(ropec + pos * 16 + i0); c1 = *(const f32x4*)(ropec + pos * 16 + i0 + 4);
                        s0 = *(const f32x4*)(ropes + pos * 16 + i0); s1 = *(const f32x4*)(ropes + pos * 16 + i0 + 4); }
                    const f32x4 x1a = acc[ai][0][m][0], x1b = acc[ai][0][m][1], x2a = acc[ai][1][m][0], x2b = acc[ai][1][m][1];
                    bf16_t* bp = dst + (size_t)r * 512 + hm * 64 + half * 32 + i0;
                    *(u32x4*)bp = pack8(x1a * c0 - x2a * s0, x1b * c1 - x2b * s1);
                    *(u32x4*)(bp + 16) = pack8(x1a * s0 + x2a * c0, x1b * s1 + x2b * c1);
                    asm volatile("" ::: "memory"); }
        } else {
#pragma unroll
            for (int ai = 0; ai < 2; ++ai)
#pragma unroll
                for (int m = 0; m < 4; ++m) { const size_t r = (size_t)(rb + ai * HALF + m * 16);
#pragma unroll
                    for (int bj = 0; bj < 2; ++bj) *(u32x4*)(V + r * 512 + (pn - 10) * 256 + bj * HALF + cl) = pack8(acc[ai][bj][m][0], acc[ai][bj][m][1]); }
        }
    }
};

struct EpiRes {
    static constexpr bool PERM = true;
    const float *xin_lat, *xin_ctx; float *xout_lat, *xout_ctx; bf16_t* Aout; const float* gate; const float* scl; float* ssq;
    __device__ __forceinline__ void operator()(AccRef acc, const Unit& u, int wr, int wc, int fr, int fq) const {
        const bool latent = u.pm < ML / BM; const int bvec = latent ? (u.pm >> 3) : 16;
        const float* xin = latent ? xin_lat : xin_ctx; float* xout = latent ? xout_lat : xout_ctx;
        const int rb = u.pm * BM + wr * 64 + fr, rsub = latent ? 0 : ML, col0 = u.pn * BM + wc * 32 + 8 * fq;
        f32x4 g[2][2], sc[2][2];
#pragma unroll
        for (int bj = 0; bj < 2; ++bj)
#pragma unroll
            for (int n = 0; n < 2; ++n) { g[bj][n] = *(const f32x4*)(gate + (size_t)bvec * 6144 + col0 + bj * HALF + 4 * n);
                sc[bj][n] = Aout ? *(const f32x4*)(scl + (size_t)bvec * 6144 + col0 + bj * HALF + 4 * n) + 1.0f : (f32x4){0.f, 0.f, 0.f, 0.f}; }
#pragma unroll
        for (int ai = 0; ai < 2; ++ai)
#pragma unroll
            for (int m = 0; m < 4; ++m) { const int r = rb + ai * HALF + m * 16; const size_t xo_off = (size_t)(r - rsub) * DM + col0; float ss = 0.f;
#pragma unroll
                for (int bj = 0; bj < 2; ++bj) { f32x4 xo[2];
#pragma unroll
                    for (int n = 0; n < 2; ++n) { const f32x4 xi = *(const f32x4*)(xin + xo_off + bj * HALF + 4 * n); xo[n] = xi + g[bj][n] * acc[ai][bj][m][n];
                        *(f32x4*)(xout + xo_off + bj * HALF + 4 * n) = xo[n]; ss += (xo[n][0] * xo[n][0] + xo[n][1] * xo[n][1]) + (xo[n][2] * xo[n][2] + xo[n][3] * xo[n][3]); }
                    if (Aout) *(u32x4*)(Aout + (size_t)r * DM + col0 + bj * HALF) = pack8(xo[0] * sc[bj][0], xo[1] * sc[bj][1]); }
                ss += __shfl_xor(ss, 16); ss += __shfl_xor(ss, 32);
                if (fq == 0) ssq[(size_t)r * 16 + u.pn * 4 + wc] = ss; }
    }
};

__device__ __forceinline__ float row_rs(const float* ssq, int r) {
    const f32x4* sp = (const f32x4*)(ssq + (size_t)r * 16); const f32x4 a = sp[0], b = sp[1], c = sp[2], d = sp[3];
    const float s = ((a[0] + a[1]) + (a[2] + a[3])) + ((b[0] + b[1]) + (b[2] + b[3])) + ((c[0] + c[1]) + (c[2] + c[3])) + ((d[0] + d[1]) + (d[2] + d[3]));
    return 1.0f / sqrtf(s * (1.0f / DM) + EPS);
}

struct EpiUp {
    static constexpr bool PERM = true;
    bf16_t* U; const float* ssq; const float* bias; int row0;
    __device__ __forceinline__ void operator()(AccRef acc, const Unit& u, int wr, int wc, int fr, int fq) const {
        const int gr0 = row0 + u.pm * BM, bvec = gr0 < ML ? (gr0 >> 11) : 16, col0 = u.pn * BM + wc * 32 + 8 * fq;
        f32x4 bv[2][2];
#pragma unroll
        for (int bj = 0; bj < 2; ++bj)
#pragma unroll
            for (int n = 0; n < 2; ++n) bv[bj][n] = *(const f32x4*)(bias + (size_t)bvec * NUP + col0 + bj * HALF + 4 * n);
#pragma unroll
        for (int ai = 0; ai < 2; ++ai)
#pragma unroll
            for (int m = 0; m < 4; ++m) { const int rl = u.pm * BM + ai * HALF + wr * 64 + m * 16 + fr; const float rs = row_rs(ssq, row0 + rl);
#pragma unroll
                for (int bj = 0; bj < 2; ++bj) *(u32x4*)(U + (size_t)rl * NUP + col0 + bj * HALF) = pack8(acc[ai][bj][m][0] * rs + bv[bj][0], acc[ai][bj][m][1] * rs + bv[bj][1]); }
    }
};

struct EpiCD {
    static constexpr bool PERM = true;
    bf16_t *Q2, *K2, *V2, *PL; const float *ssq, *bias, *ropec, *ropes;
    __device__ __forceinline__ void operator()(AccRef acc, const Unit& u, int wr, int wc, int fr, int fq) const {
        const int pn = u.pn; const bool latent = u.pm < ML / BM; const int bvec = latent ? (u.pm >> 3) : 16;
        if (!latent && pn != 2) return;
        const int rb = u.pm * BM + wr * 64 + fr, col0 = pn * BM + wc * 32 + 8 * fq;
        f32x4 bv[2][2];
#pragma unroll
        for (int bj = 0; bj < 2; ++bj)
#pragma unroll
            for (int n = 0; n < 2; ++n) bv[bj][n] = *(const f32x4*)(bias + (size_t)bvec * NCD + col0 + bj * HALF + 4 * n);
        const int half = fq >> 1, i0 = 8 * (fq & 1);
#pragma unroll
        for (int ai = 0; ai < 2; ++ai)
#pragma unroll
            for (int m = 0; m < 4; ++m) { const int r = rb + ai * HALF + m * 16; const float rs = row_rs(ssq, r);
                const f32x4 v00 = acc[ai][0][m][0] * rs + bv[0][0], v01 = acc[ai][0][m][1] * rs + bv[0][1], v10 = acc[ai][1][m][0] * rs + bv[1][0], v11 = acc[ai][1][m][1] * rs + bv[1][1];
                if (pn < 2 || (pn == 2 && wc < 2)) {
                    f32x4 c0 = (f32x4){1.f, 1.f, 1.f, 1.f}, c1 = c0, s0 = (f32x4){0.f, 0.f, 0.f, 0.f}, s1 = s0;
                    if (latent) { const int tpos = r & (SEQ - 1), pos = half ? (tpos & 63) : (tpos >> 6);
                        c0 = *(const f32x4*)(ropec + pos * 16 + i0); c1 = *(const f32x4*)(ropec + pos * 16 + i0 + 4);
                        s0 = *(const f32x4*)(ropes + pos * 16 + i0); s1 = *(const f32x4*)(ropes + pos * 16 + i0 + 4); }
                    bf16_t* bp = (pn < 2) ? Q2 + (size_t)r * 512 + (4 * pn + wc) * 64 + half * 32 + i0 : K2 + (size_t)r * 128 + wc * 64 + half * 32 + i0;
                    *(u32x4*)bp = pack8(v00 * c0 - v10 * s0, v01 * c1 - v11 * s1);
                    *(u32x4*)(bp + 16) = pack8(v00 * s0 + v10 * c0, v01 * s1 + v11 * c1);
                } else if (pn == 2) {
                    bf16_t* bp = V2 + (size_t)r * 128 + (wc - 2) * 32 + 8 * fq;
                    *(u32x4*)bp = pack8(v00, v01); *(u32x4*)(bp + 64) = pack8(v10, v11);
                } else {
                    bf16_t* bp = PL + (size_t)r * 512 + (pn - 3) * 256 + wc * 32 + 8 * fq;
                    *(u32x4*)bp = pack8(v00, v01); *(u32x4*)(bp + HALF) = pack8(v10, v11);
                }
                asm volatile("" ::: "memory");
            }
    }
};
}

__device__ __forceinline__ int colmap_ab(int n) {
    const int t = n >> 8, c = n & 255;
    if (t < 4) return ((c >> 7) ? 1024 : 512) + 128 * t + (c & 127);
    if (t < 6) return 256 * (t - 4) + c;
    if (t < 10) { const int base = t < 8 ? 1536 : 2048, tt = (t - 6) & 1, bj = c >> 7, w = (c >> 5) & 3, half = (c >> 4) & 1, i = c & 15; return base + (4 * tt + w) * 64 + half * 32 + bj * 16 + i; }
    return 2560 + 256 * (t - 10) + c;
}
__device__ __forceinline__ int colmap_cd(int n) {
    const int t = n >> 8, c = n & 255, bj = c >> 7, w = (c >> 5) & 3;
    if (t < 2) { const int half = (c >> 4) & 1, i = c & 15; return (4 * t + w) * 64 + half * 32 + bj * 16 + i; }
    if (t == 2) { const int rest = c & 31; if (w < 2) return 512 + w * 64 + (rest >> 4) * 32 + bj * 16 + (rest & 15); return 640 + bj * 64 + (w - 2) * 32 + rest; }
    return 768 + 256 * (t - 3) + c;
}
__device__ __forceinline__ int colmap_up(int n) { const int t = n >> 8, c = n & 255; return (c >> 7) * DFF + 128 * t + (c & 127); }

namespace att {
constexpr int QBLK = 32, KVBLK = 64;
constexpr int SHM_V = KVBLK * 128 * 2, SHM_K = KVBLK * 128 * 2;
constexpr int OFF_V = 0, OFF_K = 2 * SHM_V, OFF_WS = 2 * SHM_V + 2 * SHM_K, OFF_STG = 73728, STG_LD = 132;
constexpr float SCALE = 0.125f, THR = 8.f;
#define KSWZ(row, colB) ((row) * 256 + ((colB) ^ (((row) & 7) << 4)))
#define SBAR() __builtin_amdgcn_sched_barrier(0)
__device__ __forceinline__ int crow(int r, int hi) { return (r & 3) + 8 * (r >> 2) + 4 * hi; }
__device__ __forceinline__ unsigned cvtpk(float lo, float hi) { unsigned r; asm volatile("v_cvt_pk_bf16_f32 %0, %1, %2" : "=v"(r) : "v"(lo), "v"(hi)); return r; }

__device__ __forceinline__ void partialSM(f32x16& p0, f32x16& p1, float& m_reg, float& mn, float& alpha) {
  constexpr float C = SCALE * 1.4426950408889634f;
  float pmax = p0[0];
#pragma unroll
  for (int r = 1; r < 16; ++r) pmax = fmaxf(pmax, p0[r]);
#pragma unroll
  for (int r = 0; r < 16; ++r) pmax = fmaxf(pmax, p1[r]);
  { auto rr = __builtin_amdgcn_permlane32_swap(__float_as_uint(pmax), __float_as_uint(pmax), false, false);
    pmax = fmaxf(__uint_as_float(rr[0]), __uint_as_float(rr[1])); }
  if (__builtin_expect(__all(pmax - m_reg <= THR / SCALE), 1)) { mn = m_reg; alpha = 1.f; }
  else { mn = fmaxf(m_reg, pmax); alpha = __builtin_amdgcn_exp2f((m_reg - mn) * C); m_reg = mn; }
  float mnC = -mn * C;
#pragma unroll
  for (int r = 0; r < 16; ++r) p0[r] = fmaf(p0[r], C, mnC);
#pragma unroll
  for (int r = 0; r < 16; ++r) p1[r] = fmaf(p1[r], C, mnC);
#pragma unroll
  for (int r = 0; r < 16; ++r) p0[r] = __builtin_amdgcn_exp2f(p0[r]);
}
__device__ __forceinline__ void finishSM(f32x16& p0, f32x16& p1, float alpha, float& l_reg, bf16x8& pa0, bf16x8& pa1, bf16x8& pa2, bf16x8& pa3) {
#pragma unroll
  for (int r = 0; r < 16; ++r) p1[r] = __builtin_amdgcn_exp2f(p1[r]);
  float ps = 0;
#pragma unroll
  for (int r = 0; r < 16; ++r) ps += p0[r];
#pragma unroll
  for (int r = 0; r < 16; ++r) ps += p1[r];
  { auto rr = __builtin_amdgcn_permlane32_swap(__float_as_uint(ps), __float_as_uint(ps), false, false);
    ps = __uint_as_float(rr[0]) + __uint_as_float(rr[1]); }
  l_reg = l_reg * alpha + ps;
#define PK4(P, BASE, OUT) do { unsigned a0 = cvtpk(P[BASE + 0], P[BASE + 1]), a1 = cvtpk(P[BASE + 2], P[BASE + 3]);   \
    unsigned b0 = cvtpk(P[BASE + 4], P[BASE + 5]), b1 = cvtpk(P[BASE + 6], P[BASE + 7]);                              \
    auto r0 = __builtin_amdgcn_permlane32_swap(a0, b0, false, false); auto r1 = __builtin_amdgcn_permlane32_swap(a1, b1, false, false); \
    u32x4 w = {r0[0], r1[0], r0[1], r1[1]}; OUT = *reinterpret_cast<bf16x8*>(&w); } while (0)
  PK4(p0, 0, pa0); PK4(p0, 8, pa1); PK4(p1, 0, pa2); PK4(p1, 8, pa3);
#undef PK4
}
__device__ __forceinline__ void qkt(f32x16& p0, f32x16& p1, const char* Ks, const bf16x8* qr, int r32, int hi, int coff) {
  p0 = f32x16{}; p1 = f32x16{};
#pragma unroll
  for (int d0 = 0; d0 < 4; ++d0) { int cb = (coff + d0 * 16 + hi * 8) * 2;
    bf16x8 b0 = *reinterpret_cast<const bf16x8*>(Ks + KSWZ(r32, cb));
    bf16x8 b1 = *reinterpret_cast<const bf16x8*>(Ks + KSWZ(32 + r32, cb));
    p0 = __builtin_amdgcn_mfma_f32_32x32x16_bf16(b0, qr[d0], p0, 0, 0, 0);
    p1 = __builtin_amdgcn_mfma_f32_32x32x16_bf16(b1, qr[d0], p1, 0, 0, 0); }
}
__device__ __forceinline__ int v_st(int k, int c) { const int kk = (k & ~0xC) | ((k & 4) << 1) | ((k & 8) >> 1); return ((kk >> 3) * 4 + (c >> 5)) * 512 + ((kk & 7) * 32 + (c & 31)) * 2; }
__device__ __forceinline__ int v_rd_base(int lane) { return ((lane & 3) << 3) | (((lane >> 2) & 3) << 6) | (((lane >> 4) & 1) << 5) | (((lane >> 5) & 1) << 8); }
constexpr int v_rd_off(int d0, int ks, int half) { return d0 * 512 + ks * 4096 + half * 2048; }
template <int OFF> __device__ __forceinline__ s16x4 tr_read(int vb) {
  s16x4 r; asm volatile("ds_read_b64_tr_b16 %0, %1 offset:%2" : "=&v"(r) : "v"(vb), "i"(OFF) : "memory"); return r;
}
template <int D0> __device__ __forceinline__ void pv_one(f32x16& od, int vb, bf16x8 pa0, bf16x8 pa1, bf16x8 pa2, bf16x8 pa3) {
  const s16x4 l0 = tr_read<v_rd_off(D0, 0, 0)>(vb), h0 = tr_read<v_rd_off(D0, 0, 1)>(vb), l1 = tr_read<v_rd_off(D0, 1, 0)>(vb), h1 = tr_read<v_rd_off(D0, 1, 1)>(vb);
  const s16x4 l2 = tr_read<v_rd_off(D0, 2, 0)>(vb), h2 = tr_read<v_rd_off(D0, 2, 1)>(vb), l3 = tr_read<v_rd_off(D0, 3, 0)>(vb), h3 = tr_read<v_rd_off(D0, 3, 1)>(vb);
  asm volatile("s_waitcnt lgkmcnt(0)" ::: "memory"); SBAR();
#define PK(L, H) (bf16x8){L[0], L[1], L[2], L[3], H[0], H[1], H[2], H[3]}
  od = __builtin_amdgcn_mfma_f32_32x32x16_bf16(pa0, PK(l0, h0), od, 0, 0, 0);
  od = __builtin_amdgcn_mfma_f32_32x32x16_bf16(pa1, PK(l1, h1), od, 0, 0, 0);
  od = __builtin_amdgcn_mfma_f32_32x32x16_bf16(pa2, PK(l2, h2), od, 0, 0, 0);
  od = __builtin_amdgcn_mfma_f32_32x32x16_bf16(pa3, PK(l3, h3), od, 0, 0, 0);
#undef PK
}
template <int MODE> __device__ __forceinline__ void pv_all(f32x16* o, int vb, int kvh, bf16x8 pa0, bf16x8 pa1, bf16x8 pa2, bf16x8 pa3) {
  if constexpr (MODE == 0) { pv_one<0>(o[0], vb, pa0, pa1, pa2, pa3); pv_one<1>(o[1], vb, pa0, pa1, pa2, pa3); pv_one<2>(o[2], vb, pa0, pa1, pa2, pa3); pv_one<3>(o[3], vb, pa0, pa1, pa2, pa3); }
  else { if (kvh == 0) { pv_one<0>(o[0], vb, pa0, pa1, pa2, pa3); pv_one<1>(o[1], vb, pa0, pa1, pa2, pa3); } else { pv_one<2>(o[0], vb, pa0, pa1, pa2, pa3); pv_one<3>(o[1], vb, pa0, pa1, pa2, pa3); } }
}
__device__ __forceinline__ void band_mask(f32x16& p0, f32x16& p1, int dj, int hi) {
#pragma unroll
  for (int r = 0; r < 16; ++r) { const int d = dj + (r & 3) + 8 * (r >> 2) + 4 * hi;
    if ((unsigned)(d + 128) > 256u) p0[r] = -1e30f;
    if ((unsigned)(d + 160) > 256u) p1[r] = -1e30f; }
}

template <int MODE, int LDK, int NO>
__device__ __forceinline__ void attn_core(const bf16_t* Qw, const bf16_t* __restrict__ Kh, const bf16_t* __restrict__ Vh, int NT, int base0, int n0, int base1, int mbase, int coff,
                                          float m0, float l0, int kvh, f32x16 (&o)[NO], float& l_out, char* lds, const int tid) {
  const int wid = tid >> 6, lane = tid & 63, r32 = lane & 31, hi = lane >> 5;
  char* V_lds = lds + OFF_V; char* K_lds = lds + OFF_K;
  float* ws = (float*)(lds + OFF_WS) + wid * 64; float* al_l = ws + 32;
  float m_reg = m0, l_reg = l0; bf16x8 qr[4];
#pragma unroll
  for (int d = 0; d < NO; ++d) o[d] = f32x16{};
#pragma unroll
  for (int d0 = 0; d0 < 4; ++d0) qr[d0] = *reinterpret_cast<const bf16x8*>(Qw + d0 * 16);
  const int sr = tid >> 4, sc = (tid & 15) * 8, vst0 = v_st(sr, sc), vst1 = v_st(32 + sr, sc);
  const int vb0 = (int)(uintptr_t)V_lds + v_rd_base(lane);
  struct { bf16x8 vs0, vs1, ks0, ks1; } sr_[2];
#define TROW(j) ((long)((j) < n0 ? base0 + 64 * (j) : base1 + 64 * ((j) - n0)))
#define SLOAD(i, j) do { const long _r = TROW(j); sr_[i].vs0 = *reinterpret_cast<const bf16x8*>(&Vh[(_r + sr) * LDK + sc]); sr_[i].vs1 = *reinterpret_cast<const bf16x8*>(&Vh[(_r + 32 + sr) * LDK + sc]); \
    sr_[i].ks0 = *reinterpret_cast<const bf16x8*>(&Kh[(_r + sr) * LDK + sc]); sr_[i].ks1 = *reinterpret_cast<const bf16x8*>(&Kh[(_r + 32 + sr) * LDK + sc]); } while (0)
#define SWRITE(b, i) do { *(bf16x8*)(V_lds + (b) * SHM_V + vst0) = sr_[i].vs0;          \
    *(bf16x8*)(V_lds + (b) * SHM_V + vst1) = sr_[i].vs1; int kc = sc * 2;               \
    *(bf16x8*)(K_lds + (b) * SHM_K + KSWZ(sr, kc)) = sr_[i].ks0;                       \
    *(bf16x8*)(K_lds + (b) * SHM_K + KSWZ(32 + sr, kc)) = sr_[i].ks1; } while (0)
#define SWAIT() asm volatile("s_waitcnt vmcnt(4)" ::: "memory")
#define RESC(a) do { if (__any((a) < 1.f)) { if (hi == 0) al_l[r32] = (a); asm volatile("s_waitcnt lgkmcnt(0)" ::: "memory"); \
    _Pragma("unroll") for (int d = 0; d < NO; ++d) _Pragma("unroll") for (int r = 0; r < 16; ++r) o[d][r] *= al_l[crow(r, hi)]; } } while (0)
#define MASKT(P0, P1, j) do { if constexpr (MODE == 1) { if ((j) >= 4) band_mask(P0, P1, mbase + 64 * ((j) - 4), hi); } } while (0)
  f32x16 pA0, pA1, pB0, pB1; float mnA, mnB, alA, alB; bf16x8 pa0, pa1, pa2, pa3;
  constexpr int SE = 0, SO = 1;
  SLOAD(SE, 0); asm volatile("s_waitcnt vmcnt(0)" ::: "memory"); SWRITE(0, SE); __syncthreads();
  qkt(pA0, pA1, K_lds, qr, r32, hi, coff); MASKT(pA0, pA1, 0); partialSM(pA0, pA1, m_reg, mnA, alA);
  SLOAD(SO, 1); if (2 < NT) SLOAD(SE, 2);
  SWAIT(); SWRITE(1, SO); __syncthreads();
  for (int j = 1; j + 1 < NT; j += 2) {
    SBAR(); qkt(pB0, pB1, K_lds + SHM_K, qr, r32, hi, coff); MASKT(pB0, pB1, j);
    finishSM(pA0, pA1, alA, l_reg, pa0, pa1, pa2, pa3); SBAR();
    SLOAD(SO, j + 2); SBAR();
    pv_all<MODE>(o, vb0, kvh, pa0, pa1, pa2, pa3); partialSM(pB0, pB1, m_reg, mnB, alB);
    __syncthreads(); SWAIT(); SWRITE(0, SE);
    RESC(alB); __syncthreads();
    SBAR(); qkt(pA0, pA1, K_lds, qr, r32, hi, coff); MASKT(pA0, pA1, j + 1);
    finishSM(pB0, pB1, alB, l_reg, pa0, pa1, pa2, pa3); SBAR();
    if (j + 3 < NT) SLOAD(SE, j + 3); SBAR();
    pv_all<MODE>(o, vb0 + SHM_V, kvh, pa0, pa1, pa2, pa3); partialSM(pA0, pA1, m_reg, mnA, alA);
    __syncthreads(); SWAIT(); SWRITE(1, SO);
    RESC(alA); __syncthreads();
  }
  SBAR(); qkt(pB0, pB1, K_lds + SHM_K, qr, r32, hi, coff); MASKT(pB0, pB1, NT - 1);
  finishSM(pA0, pA1, alA, l_reg, pa0, pa1, pa2, pa3); SBAR();
  pv_all<MODE>(o, vb0, kvh, pa0, pa1, pa2, pa3); partialSM(pB0, pB1, m_reg, mnB, alB);
  __syncthreads(); RESC(alB);
  finishSM(pB0, pB1, alB, l_reg, pa0, pa1, pa2, pa3); SBAR();
  pv_all<MODE>(o, vb0 + SHM_V, kvh, pa0, pa1, pa2, pa3);
  l_out = l_reg;
#undef TROW
#undef SLOAD
#undef SWRITE
#undef SWAIT
#undef RESC
#undef MASKT
}

__device__ __forceinline__ void diff_unit(const bf16_t* Qb, const bf16_t* Kb, const bf16_t* Vb, bf16_t* Aout, int b, int h, int qb, int isctx, float lam, const float* subln, char* lds, const int tid) {
  const int wid = __builtin_amdgcn_readfirstlane(tid >> 6), lane = tid & 63, r32 = lane & 31, hi = lane >> 5;
  const int map = wid >> 2, wq = wid & 3;
  const int cbase = ML + b * CTXL;
  const int qrow0 = isctx ? cbase + qb * 128 : b * SEQ + qb * 128;
  const int NT = isctx ? 4 : 36, base0 = isctx ? cbase : b * SEQ, n0 = isctx ? 4 : 32;
  const bf16_t* Qw = Qb + (size_t)(qrow0 + wq * 32 + r32) * 512 + h * 128 + map * 64 + hi * 8;
  f32x16 o[4]; float l_reg;
  attn_core<0, 512, 4>(Qw, Kb + h * 128, Vb + h * 128, NT, base0, n0, cbase, 0, map * 64, -1e30f, 0.f, 0, o, l_reg, lds, tid);
  float* ws = (float*)(lds + OFF_WS) + wid * 64;
  if (hi == 0) ws[r32] = l_reg;
  asm volatile("s_waitcnt lgkmcnt(0)" ::: "memory");
  float* stg = (float*)(lds + OFF_STG);
  const float sgn = map ? -lam : 1.f;
  float rli[16];
#pragma unroll
  for (int r = 0; r < 16; ++r) rli[r] = sgn * __builtin_amdgcn_rcpf(ws[crow(r, hi)]);
  if (map == 1) {
#pragma unroll
    for (int r = 0; r < 16; ++r)
#pragma unroll
      for (int d0 = 0; d0 < 4; ++d0) stg[(wq * 32 + crow(r, hi)) * STG_LD + d0 * 32 + r32] = o[d0][r] * rli[r];
  }
  __syncthreads();
  if (map == 0) {
#pragma unroll
    for (int r = 0; r < 16; ++r)
#pragma unroll
      for (int d0 = 0; d0 < 4; ++d0) stg[(wq * 32 + crow(r, hi)) * STG_LD + d0 * 32 + r32] += o[d0][r] * rli[r];
  }
  __syncthreads();
  { const int row = tid >> 2, part = tid & 3; const float* sp = stg + row * STG_LD + part * 32; f32x4 v[8]; float ss = 0.f;
#pragma unroll
    for (int i = 0; i < 8; ++i) { v[i] = *(const f32x4*)(sp + 4 * i); ss += (v[i][0] * v[i][0] + v[i][1] * v[i][1]) + (v[i][2] * v[i][2] + v[i][3] * v[i][3]); }
    ss += __shfl_xor(ss, 1); ss += __shfl_xor(ss, 2);
    const float rn = 0.8f / sqrtf(ss * (1.f / 128.f) + EPS);
    bf16_t* op = Aout + (size_t)(qrow0 + row) * DM + 512 + h * 128 + part * 32;
#pragma unroll
    for (int i = 0; i < 4; ++i) { const f32x4 w0 = *(const f32x4*)(subln + part * 32 + 8 * i), w1 = *(const f32x4*)(subln + part * 32 + 8 * i + 4);
      *(u32x4*)(op + 8 * i) = pack8(v[2 * i] * w0 * rn, v[2 * i + 1] * w1 * rn); }
  }
  __syncthreads();
}

__device__ __forceinline__ void win_unit(const bf16_t* Q2, const bf16_t* K2, const bf16_t* V2, bf16_t* Aout, int b, int qb, int g, const float* sink, char* lds, const int tid) {
  const int wid = __builtin_amdgcn_readfirstlane(tid >> 6), lane = tid & 63, r32 = lane & 31, hi = lane >> 5;
  const int kvh = wid >> 2, wq = wid & 3, head = kvh * 4 + g;
  const int q0 = qb * 128, lo = q0 >= 128 ? q0 - 128 : 0, hk = (q0 + 256 <= SEQ) ? q0 + 256 : SEQ, NT = 4 + (hk - lo) / 64;
  const int qrow0 = b * SEQ + q0, cbase = ML + b * CTXL;
  const bf16_t* Qw = Q2 + (size_t)(qrow0 + wq * 32 + r32) * 512 + head * 64 + hi * 8;
  const int mbase = lo - q0 - wq * 32 - r32;
  f32x16 o[2]; float l_reg;
  attn_core<1, 128, 2>(Qw, K2, V2, NT, cbase, 4, b * SEQ + lo, mbase, kvh * 64, sink[head] * 8.0f, 1.0f, kvh, o, l_reg, lds, tid);
  float* ws = (float*)(lds + OFF_WS) + wid * 64;
  if (hi == 0) ws[r32] = l_reg;
  asm volatile("s_waitcnt lgkmcnt(0)" ::: "memory");
  float rli[16];
#pragma unroll
  for (int r = 0; r < 16; ++r) rli[r] = __builtin_amdgcn_rcpf(ws[crow(r, hi)]);
  bf16_t* op = Aout + (size_t)(qrow0 + wq * 32) * DM + head * 64 + r32;
#pragma unroll
  for (int r = 0; r < 16; ++r)
#pragma unroll
    for (int dl = 0; dl < 2; ++dl) op[(size_t)crow(r, hi) * DM + dl * 32] = (bf16_t)f2bf(o[dl][r] * rli[r]);
  __syncthreads();
}
#undef KSWZ
#undef SBAR
}

#define XB_TMO      128
#define XB_XCNT(j)  (256  + 64 * (j))
#define XB_XSUB(j)  (1280 + 64 * (j))
#define XB_XGEN(j)  (2304 + 64 * (j))
#define XB_TOP      3328
#define XB_TOPGEN   3392
#define XCD_BAR_WORDS 3456
#define XB_SPIN_CAP (1u << 18)
__device__ __forceinline__ unsigned xb_ld(unsigned* p)              { return __hip_atomic_load(p, __ATOMIC_RELAXED, __HIP_MEMORY_SCOPE_AGENT); }
__device__ __forceinline__ unsigned xb_add(unsigned* p, unsigned v) { return __hip_atomic_fetch_add(p, v, __ATOMIC_RELAXED, __HIP_MEMORY_SCOPE_AGENT); }
__device__ __forceinline__ unsigned xb_xcc_id() { return (unsigned)__builtin_amdgcn_s_getreg((3 << 11) | 20) & 0xFu; }
#define XB_SPIN(cond, bar) do { unsigned _sp = 0; while (cond) { __builtin_amdgcn_s_sleep(1); \
    if ((++_sp & 255u) == 0u) { if (xb_ld(&(bar)[XB_TMO])) break; if (_sp > XB_SPIN_CAP) { atomicAdd(&(bar)[XB_TMO], 1u); break; } } } } while (0)
struct XcdBarrier { unsigned* bar; unsigned x; volatile LAS unsigned* st; };
__device__ __forceinline__ XcdBarrier xcd_barrier_post(unsigned* bar, volatile LAS unsigned* st) {
    XcdBarrier b; b.bar = bar; b.x = xb_xcc_id(); b.st = st;
    if (threadIdx.x == 0) (void)xb_add(&bar[XB_XCNT(b.x)], 1u);
    return b;
}
__device__ __forceinline__ void xcd_barrier_complete(unsigned* bar, unsigned x, unsigned& nloc, unsigned& nx) {
    const unsigned G = gridDim.x * gridDim.y * gridDim.z;
    unsigned sum, cnt, mine, sp = 0u;
    for (;;) {
        sum = 0u; cnt = 0u; mine = 0u;
#pragma unroll
        for (unsigned j = 0; j < 16; ++j) { const unsigned c = xb_ld(&bar[XB_XCNT(j)]); sum += c; cnt += (c > 0u) ? 1u : 0u; mine = (j == x) ? c : mine; }
        if (sum == G) break;
        __builtin_amdgcn_s_sleep(1);
        if ((++sp & 255u) == 0u) { if (xb_ld(&bar[XB_TMO])) break; if (sp > XB_SPIN_CAP) { atomicAdd(&bar[XB_TMO], 1u); break; } }
    }
    nloc = mine > 0u ? mine : 1u; nx = cnt > 0u ? cnt : 1u;
}
__device__ __forceinline__ void xcd_barrier(const XcdBarrier& b) {
    asm volatile("s_waitcnt vmcnt(0)" ::: "memory");
    __syncthreads();
    if (threadIdx.x == 0) {
        unsigned* bar = b.bar;
        __builtin_amdgcn_s_waitcnt(0);
        unsigned nloc = b.st[0], nx = b.st[1];
        if (nloc == 0u) { xcd_barrier_complete(bar, b.x, nloc, nx); b.st[0] = nloc; b.st[1] = nx; }
        const unsigned old = xb_add(&bar[XB_XSUB(b.x)], 1u);
        const unsigned gen = old / nloc;
        if (old + 1u == (gen + 1u) * nloc) {
            __builtin_amdgcn_fence(__ATOMIC_RELEASE, "agent");
            asm volatile("s_waitcnt vmcnt(0)" ::: "memory");
            const unsigned og = xb_add(&bar[XB_TOP], 1u);
            const unsigned tg = og / nx;
            if (og + 1u == (tg + 1u) * nx) xb_add(&bar[XB_TOPGEN], 1u);
            else XB_SPIN(xb_ld(&bar[XB_TOPGEN]) == tg, bar);
            __builtin_amdgcn_fence(__ATOMIC_ACQUIRE, "agent");
            xb_add(&bar[XB_XGEN(b.x)], 1u);
            asm volatile("s_waitcnt vmcnt(0)" ::: "memory");
        } else {
            XB_SPIN(xb_ld(&bar[XB_XGEN(b.x)]) == gen, bar);
            __builtin_amdgcn_fence(__ATOMIC_ACQUIRE, "agent");
            asm volatile("s_waitcnt vmcnt(0)" ::: "memory");
        }
    }
    __syncthreads();
}

constexpr int RING_BYTES = 131072, LDS_BYTES = 147456, LDSCTL_OFF = LDS_BYTES - 512, MISC_OFF = LDSCTL_OFF + 320;
#define LDS_WAIT() asm volatile("s_waitcnt lgkmcnt(0)" ::: "memory")

struct Args { const float* in[21]; float* out; unsigned char* ws; int lo, hi; };

enum { ST_PREPA = 0, ST_PREPB = 1, ST_INAB = 2, ST_ATT0 = 3, ST_OUTAB = 4, ST_FFN0 = 5  , ST_DOWN0 = 23, ST_INCD = 24, ST_ATT1 = 25, ST_OUTCD = 26, ST_FFN1 = 27  ,
       ST_DOWN1 = 43, ST_FINAL = 44, N_STEPS = 45 };

template <int MAP> __device__ __forceinline__ int cmap(int n) { if constexpr (MAP == 1) return colmap_ab(n); else if constexpr (MAP == 2) return colmap_cd(n); else if constexpr (MAP == 3) return colmap_up(n); else return n; }
template <int MAP>
__device__ __forceinline__ void transpose_item(const float* W, int K, int N, bf16_t* WT, LAS float* scr, int item, int lane) {
    const int nblk = N / 32, kb = item / nblk, nb = item % nblk, k0 = 64 * kb, n0 = 32 * nb;
    const int srcc = cmap<MAP>(n0 + (lane & 31));
#pragma unroll 8
    for (int i = 0; i < 32; ++i) { const int kk = 2 * i + (lane >> 5); scr[kk * 33 + (lane & 31)] = W[(size_t)(k0 + kk) * N + srcc]; }
    LDS_WAIT(); asm volatile("" ::: "memory");
    const int c = lane & 7;
#pragma unroll
    for (int j = 0; j < 4; ++j) { const int n = (lane >> 3) + 8 * j; const LAS float* s = scr + (8 * c) * 33 + n;
        u32x4 o; o.x = cvt_pk_bf16(s[0 * 33], s[1 * 33]); o.y = cvt_pk_bf16(s[2 * 33], s[3 * 33]); o.z = cvt_pk_bf16(s[4 * 33], s[5 * 33]); o.w = cvt_pk_bf16(s[6 * 33], s[7 * 33]);
        *(u32x4*)(WT + (size_t)(n0 + n) * K + k0 + 8 * c) = o; }
    LDS_WAIT(); asm volatile("" ::: "memory");
}

enum { K_PREPA = 0, K_PREPB, K_INAB, K_ATT0, K_RES, K_UP, K_GATE, K_INCD, K_ATT1, K_FINAL, N_KINDS };
__host__ __device__ __forceinline__ int step_kind(int step) {
    if (step == ST_PREPA) return K_PREPA; if (step == ST_PREPB) return K_PREPB; if (step == ST_INAB) return K_INAB; if (step == ST_ATT0) return K_ATT0;
    if (step == ST_OUTAB || step == ST_DOWN0 || step == ST_OUTCD || step == ST_DOWN1) return K_RES;
    if (step == ST_INCD) return K_INCD; if (step == ST_ATT1) return K_ATT1; if (step == ST_FINAL) return K_FINAL;
    const int sub = step >= ST_FFN1 ? step - ST_FFN1 : step - ST_FFN0; return (sub & 1) ? K_GATE : K_UP;
}
#ifndef PHASE_MASK
#define PHASE_MASK 0x3ff
#endif
#define HAS(k) ((KIND < 0 && ((PHASE_MASK >> (k)) & 1)) || KIND == (k))
template <int KIND>
__global__ void __launch_bounds__(NWAVES * 64, 2) fwd_kernel(Args args) {
    extern __shared__ __attribute__((aligned(16))) unsigned char lds[];
    LAS unsigned char* ldsl = (LAS unsigned char*)lds;
    volatile LAS unsigned* MISC = (volatile LAS unsigned*)(ldsl + MISC_OFF);
    const int tid0 = threadIdx.x;
    const int G = gridDim.x, bx = blockIdx.x;
    for (int u = tid0; u < (LDS_BYTES - LDSCTL_OFF) / 4; u += NWAVES * 64) ((LAS unsigned*)(ldsl + LDSCTL_OFF))[u] = 0u;
    __syncthreads();
    XcdBarrier bar; bar.bar = (unsigned*)(args.ws + WS_CTL) + CW_BAR; bar.x = 0; bar.st = nullptr;
    if (ONE_LAUNCH) bar = xcd_barrier_post((unsigned*)(args.ws + WS_CTL) + CW_BAR, MISC + 8);

    for (int step = args.lo; step < args.hi; ++step) {
        const int kind = step_kind(step);
        int bxs = bx; asm volatile("" : "+s"(bxs));
        int tid = tid0; asm volatile("" : "+v"(tid));
        unsigned char* ws = args.ws; asm volatile("" : "+s"(ws));
        const int lane = tid & 63, wave = __builtin_amdgcn_readfirstlane(tid >> 6);
        const int vcu = (G % 8 == 0) ? (bxs % 8) * (G / 8) + bxs / 8 : bxs;
        const int gw = vcu * NWAVES + wave, NGW = G * NWAVES;
        const float* x = args.in[0]; const float* cvec = args.in[1]; const float* ctx = args.in[2]; const float* cctx = args.in[3];
        const float* w_mod = args.in[4]; const float* b_mod = args.in[5]; const float* w_in_ab = args.in[6]; const float* conv_a = args.in[7];
        const float* lam_qk = args.in[8]; const float* subln = args.in[9]; const float* w_out_ab = args.in[10]; const float* w_in_cd = args.in[11];
        const float* sink_c = args.in[12]; const float* pool_w = args.in[13]; const float* pool_scale = args.in[14]; const float* w_out_cd = args.in[15];
        const float* w_up = args.in[16]; const float* conv_w = args.in[17]; const float* conv_b = args.in[18]; const float* w_down = args.in[19];
        const float* fnw = args.in[20];
        float* out = args.out;
        float* mods = (float*)(ws + WS_MODS); float* bup0 = (float*)(ws + WS_BUP0); float* bup1 = (float*)(ws + WS_BUP1); float* bcd = (float*)(ws + WS_BCD);
        float* ropec = (float*)(ws + WS_ROPEC); float* ropes = (float*)(ws + WS_ROPES); float* lamp = (float*)(ws + WS_LAM);
        bf16_t* Wab = (bf16_t*)(ws + WS_WAB); bf16_t* Woab = (bf16_t*)(ws + WS_WOAB); bf16_t* Wcd = (bf16_t*)(ws + WS_WCD); bf16_t* Wocd = (bf16_t*)(ws + WS_WOCD);
        bf16_t* Wup0 = (bf16_t*)(ws + WS_WUP0); bf16_t* Wup1 = (bf16_t*)(ws + WS_WUP1); bf16_t* Wdn0 = (bf16_t*)(ws + WS_WDN0); bf16_t* Wdn1 = (bf16_t*)(ws + WS_WDN1);
        float* XC = (float*)(ws + WS_XC); float* ssqA = (float*)(ws + WS_SSQA); float* ssqB = (float*)(ws + WS_SSQB);
        bf16_t* A1 = (bf16_t*)(ws + WS_A1); bf16_t* A2 = (bf16_t*)(ws + WS_A2);
        bf16_t* GB = (bf16_t*)(ws + WS_GB); bf16_t* Pb = (bf16_t*)(ws + WS_P); bf16_t* Qb = (bf16_t*)(ws + WS_Q); bf16_t* Kb = (bf16_t*)(ws + WS_K); bf16_t* Vb = (bf16_t*)(ws + WS_V);
        bf16_t* ACT = (bf16_t*)(ws + WS_ACT); bf16_t* Q2 = (bf16_t*)(ws + WS_Q2); bf16_t* PL = (bf16_t*)(ws + WS_PL); bf16_t* K2 = (bf16_t*)(ws + WS_K2); bf16_t* V2 = (bf16_t*)(ws + WS_V2);
        bf16_t* Ub = (bf16_t*)(ws + WS_U);
        if (HAS(K_PREPA) && kind == K_PREPA) {
            if (bxs < 192) {
                const int l = bxs / 96, nc = bxs % 96;
                LAS float* st = (LAS float*)ldsl;
                for (int e = tid; e < 17 * 1024; e += NWAVES * 64) { const int v = e >> 10, k = e & 1023; const float xv = v < 16 ? cvec[v * 1024 + k] : cctx[k]; st[k * 20 + v] = xv / (1.0f + expf(-xv)); }
                __syncthreads();
                float acc[17];
#pragma unroll
                for (int v = 0; v < 17; ++v) acc[v] = 0.f;
                const float* wp = w_mod + (size_t)l * 1024 * 6144 + nc * 64 + lane;
                for (int k0 = wave * 128; k0 < wave * 128 + 128; k0 += 8) {
                    float wv[8];
#pragma unroll
                    for (int uu = 0; uu < 8; ++uu) wv[uu] = wp[(size_t)(k0 + uu) * 6144];
#pragma unroll
                    for (int uu = 0; uu < 8; ++uu) { const LAS f32x4* sp = (const LAS f32x4*)(st + (k0 + uu) * 20);
                        const f32x4 s0 = sp[0], s1 = sp[1], s2 = sp[2], s3 = sp[3]; const float s16 = st[(k0 + uu) * 20 + 16];
#pragma unroll
                        for (int j = 0; j < 4; ++j) { acc[j] += s0[j] * wv[uu]; acc[4 + j] += s1[j] * wv[uu]; acc[8 + j] += s2[j] * wv[uu]; acc[12 + j] += s3[j] * wv[uu]; }
                        acc[16] += s16 * wv[uu]; }
                }
                LAS float* red = (LAS float*)(ldsl + 81920);
#pragma unroll
                for (int v = 0; v < 17; ++v) red[(wave * 17 + v) * 64 + lane] = acc[v];
                __syncthreads();
                for (int e = tid; e < 17 * 64; e += NWAVES * 64) { const int v = e >> 6, ln = e & 63; float s = 0.f;
#pragma unroll
                    for (int w = 0; w < 8; ++w) s += red[(w * 17 + v) * 64 + ln];
                    const int n = nc * 64 + ln; mods[(size_t)(l * 17 + v) * 6144 + n] = s + b_mod[l * 6144 + n]; }
                __syncthreads();
            } else if (bxs == 192) {
                for (int e = tid; e < 1024; e += NWAVES * 64) { const int pos = e >> 4, i = e & 15;
                    const float inv = __builtin_amdgcn_exp2f(-(float)i * (13.287712379549449f / 16.0f)); const float ang = (float)pos * inv;
                    double xr = (double)ang; const double n2 = rint(xr * 0.15915494309189535); xr -= n2 * 6.283185307179586;
                    double sn = xr, cs = 1.0, ts = xr, tc = 1.0; const double x2 = xr * xr;
                    for (int q = 1; q < 16; ++q) { tc *= -x2 / (double)((2 * q - 1) * (2 * q)); ts *= -x2 / (double)((2 * q) * (2 * q + 1)); cs += tc; sn += ts; }
                    ropec[e] = (float)cs; ropes[e] = (float)sn; }
            } else if (bxs == 193) {
                if (tid == 0) { float d1 = 0.f, d2 = 0.f; for (int i = 0; i < 64; ++i) { d1 += lam_qk[i] * lam_qk[64 + i]; d2 += lam_qk[128 + i] * lam_qk[192 + i]; }
                    lamp[0] = expf(d1) - expf(d2) + 0.2f; }
            }
            {
                LAS float* scr = (LAS float*)(ldsl + wave * 16384);
                constexpr int I_AB = 16 * 96, I_OAB = 16 * 32, I_CD = 16 * 40, I_OCD = 8 * 32, I_UP = 16 * 176, I_DN = 44 * 32;
                constexpr int NITEMS = I_AB + I_OAB + I_CD + I_OCD + 2 * I_UP + 2 * I_DN;
                for (int it = gw; it < NITEMS; it += NGW) {
                    int r = it;
                    if (r < I_AB) { transpose_item<1>(w_in_ab, 1024, NAB, Wab, scr, r, lane); continue; } r -= I_AB;
                    if (r < I_OAB) { transpose_item<0>(w_out_ab, 1024, 1024, Woab, scr, r, lane); continue; } r -= I_OAB;
                    if (r < I_CD) { transpose_item<2>(w_in_cd, 1024, NCD, Wcd, scr, r, lane); continue; } r -= I_CD;
                    if (r < I_OCD) { transpose_item<0>(w_out_cd, 1024, 1024, Wocd, scr, r, lane); continue; } r -= I_OCD;
                    if (r < I_UP) { transpose_item<3>(w_up, 1024, NUP, Wup0, scr, r, lane); continue; } r -= I_UP;
                    if (r < I_UP) { transpose_item<3>(w_up + (size_t)1024 * NUP, 1024, NUP, Wup1, scr, r, lane); continue; } r -= I_UP;
                    if (r < I_DN) { transpose_item<0>(w_down, DFF, 1024, Wdn0, scr, r, lane); continue; } r -= I_DN;
                    transpose_item<0>(w_down + (size_t)DFF * 1024, DFF, 1024, Wdn1, scr, r, lane);
                }
                for (int it = gw; it < 512 * 16; it += NGW) { const int kp = it >> 4, nch = it & 15, gq = kp >> 7, n = nch * 64 + lane; float s = 0.f;
                    const float* pw = pool_w + (size_t)kp * 128; const float* psc = pool_scale + gq * 128; const float* wo = w_out_cd + (size_t)(512 + gq * 128) * 1024 + n;
#pragma unroll 8
                    for (int e = 0; e < 128; ++e) s += pw[e] * psc[e] * wo[(size_t)e * 1024];
                    Wocd[(size_t)n * 1024 + 512 + kp] = (bf16_t)f2bf(s); }
            }
        }
        else if (HAS(K_PREPB) && kind == K_PREPB) {
            for (int m = gw; m < MT; m += NGW) {
                const float* xr = m < ML ? x + (size_t)m * DM : ctx + (size_t)(m - ML) * DM; const int bvec = m < ML ? (m >> 11) : 16;
                const f32x4* xp = (const f32x4*)xr + lane; f32x4 v[4]; float ss = 0.f;
#pragma unroll
                for (int j = 0; j < 4; ++j) { v[j] = xp[64 * j]; ss += (v[j][0] * v[j][0] + v[j][1] * v[j][1]) + (v[j][2] * v[j][2] + v[j][3] * v[j][3]); }
                const float rs = 1.0f / sqrtf(wave_sum(ss) * (1.0f / DM) + EPS);
                const f32x4* shp = (const f32x4*)(mods + (size_t)bvec * 6144) + lane; const f32x4* scp = (const f32x4*)(mods + (size_t)bvec * 6144 + 1024) + lane;
                u32x2* op = (u32x2*)(A1 + (size_t)m * DM) + lane;
#pragma unroll
                for (int j = 0; j < 4; ++j) { const f32x4 h = v[j] * rs * (scp[64 * j] + 1.0f) + shp[64 * j]; u32x2 w; w.x = cvt_pk_bf16(h[0], h[1]); w.y = cvt_pk_bf16(h[2], h[3]); op[64 * j] = w; }
            }
            for (int it = gw; it < 2 * NUP + NCD; it += NGW) {
                const bf16_t* wt; const float* sh; float* bo; int n, N;
                if (it < NUP) { n = it; N = NUP; wt = Wup0; sh = mods + 3 * 1024; bo = bup0; }
                else if (it < 2 * NUP) { n = it - NUP; N = NUP; wt = Wup1; sh = mods + (size_t)17 * 6144 + 3 * 1024; bo = bup1; }
                else { n = it - 2 * NUP; N = NCD; wt = Wcd; sh = mods + (size_t)17 * 6144; bo = bcd; }
                const u32x4* wp = (const u32x4*)(wt + (size_t)n * 1024 + lane * 16); float wf[16]; { float t8[8]; unpack8(wp[0], t8);
#pragma unroll
                    for (int j = 0; j < 8; ++j) wf[j] = t8[j]; unpack8(wp[1], t8);
#pragma unroll
                    for (int j = 0; j < 8; ++j) wf[8 + j] = t8[j]; }
                for (int v = 0; v < 17; ++v) { const f32x4* sp = (const f32x4*)(sh + (size_t)v * 6144 + lane * 16); float p = 0.f;
#pragma unroll
                    for (int j = 0; j < 4; ++j) { const f32x4 s = sp[j]; p += (s[0] * wf[4 * j] + s[1] * wf[4 * j + 1]) + (s[2] * wf[4 * j + 2] + s[3] * wf[4 * j + 3]); }
                    p = wave_sum(p); if (lane == 0) bo[(size_t)v * N + n] = p; }
            }
        }
        else if (HAS(K_INAB) && kind == K_INAB) {
            pg8::Gemm g{A1, Wab, MT, NAB, 1024}; pg8::StaticOrder S; S.init(MT, NAB, G, bxs);
            pg8::EpiAB E{GB, Pb, Qb, Kb, Vb, ropec, ropes};
            pg8::gemm_phase<pg8::EpiAB, pg8::StaticOrder, true, true>(ldsl, g, S, E, tid);
        }
        else if (HAS(K_ATT0) && kind == K_ATT0) {
            const float lam = lamp[0];
            for (int ui = vcu; ui < 1024 + 128; ui += G) {
                if (ui < 1024) { const int bh = ui >> 4, qb = ui & 15; att::diff_unit(Qb, Kb, Vb, A2, bh >> 2, bh & 3, qb, 0, lam, subln, (char*)lds, tid); }
                else { const int uc = ui - 1024, bh = uc >> 1, qb = uc & 1; att::diff_unit(Qb, Kb, Vb, A2, bh >> 2, bh & 3, qb, 1, lam, subln, (char*)lds, tid); }
            }
            for (int it = vcu; it < MT / 64; it += G) {
                for (int e = tid; e < 64 * 64; e += NWAVES * 64) { const int r = it * 64 + (e >> 6), c = (e & 63) * 8;
                    const int L = r < ML ? SEQ : CTXL, pos = r < ML ? (r & (SEQ - 1)) : ((r - ML) & (CTXL - 1));
                    float pc[8], pm[8], pp[8], gbv[8];
                    unpack8(*(const u32x4*)(Pb + (size_t)r * 512 + c), pc); unpack8(*(const u32x4*)(GB + (size_t)r * 512 + c), gbv);
                    if (pos > 0) unpack8(*(const u32x4*)(Pb + (size_t)(r - 1) * 512 + c), pm); else {
#pragma unroll
                        for (int j = 0; j < 8; ++j) pm[j] = 0.f; }
                    if (pos < L - 1) unpack8(*(const u32x4*)(Pb + (size_t)(r + 1) * 512 + c), pp); else {
#pragma unroll
                        for (int j = 0; j < 8; ++j) pp[j] = 0.f; }
                    const f32x4 w0a = *(const f32x4*)(conv_a + c), w0b = *(const f32x4*)(conv_a + c + 4), w1a = *(const f32x4*)(conv_a + 512 + c), w1b = *(const f32x4*)(conv_a + 512 + c + 4),
                                w2a = *(const f32x4*)(conv_a + 1024 + c), w2b = *(const f32x4*)(conv_a + 1024 + c + 4);
                    f32x4 oa, ob;
#pragma unroll
                    for (int j = 0; j < 4; ++j) { oa[j] = gbv[j] * (w0a[j] * pm[j] + w1a[j] * pc[j] + w2a[j] * pp[j]); ob[j] = gbv[4 + j] * (w0b[j] * pm[4 + j] + w1b[j] * pc[4 + j] + w2b[j] * pp[4 + j]); }
                    *(u32x4*)(A2 + (size_t)r * DM + c) = pack8(oa, ob); }
            }
        }
        else if (HAS(K_RES) && kind == K_RES) {
            pg8::Gemm g; pg8::EpiRes E; int M;
            if (step == ST_OUTAB) { M = MT; g = pg8::Gemm{A2, Woab, MT, 1024, 1024}; E = pg8::EpiRes{x, ctx, out, XC, A1, mods + 2 * 1024, mods + 4 * 1024, ssqA}; }
            else if (step == ST_DOWN0) { M = MT; g = pg8::Gemm{ACT, Wdn0, MT, 1024, DFF}; E = pg8::EpiRes{out, XC, out, XC, A2, mods + 5 * 1024, mods + (size_t)17 * 6144 + 1024, ssqB}; }
            else if (step == ST_OUTCD) { M = ML; g = pg8::Gemm{A1, Wocd, ML, 1024, 1024}; E = pg8::EpiRes{out, XC, out, XC, A2, mods + (size_t)17 * 6144 + 2 * 1024, mods + (size_t)17 * 6144 + 4 * 1024, ssqA}; }
            else { M = ML; g = pg8::Gemm{ACT, Wdn1, ML, 1024, DFF}; E = pg8::EpiRes{out, XC, out, XC, nullptr, mods + (size_t)17 * 6144 + 5 * 1024, nullptr, ssqB}; }
            pg8::StaticOrder S; S.init(M, 1024, G, bxs);
            pg8::gemm_phase<pg8::EpiRes, pg8::StaticOrder, true, true>(ldsl, g, S, E, tid);
        }
        else if ((HAS(K_UP) || HAS(K_GATE)) && (kind == K_UP || kind == K_GATE)) {
            const int layer = step >= ST_FFN1 ? 1 : 0, sub = step - (layer ? ST_FFN1 : ST_FFN0), chunk = sub >> 1, row0 = chunk * CH_ROWS;
            if (HAS(K_UP) && kind == K_UP) {
                pg8::Gemm g{(layer ? A2 : A1) + (size_t)row0 * DM, layer ? Wup1 : Wup0, CH_ROWS, NUP, 1024}; pg8::StaticOrder S; S.init(CH_ROWS, NUP, G, bxs);
                pg8::EpiUp E{Ub, ssqA, layer ? bup1 : bup0, row0};
                pg8::gemm_phase<pg8::EpiUp, pg8::StaticOrder, true, true>(ldsl, g, S, E, tid);
            } else if (HAS(K_GATE) && kind == K_GATE) {
                const float* cw = conv_w + (size_t)layer * 3 * NUP; const float* cb = conv_b + (size_t)layer * NUP;
                const int total = CH_ROWS * 22 * 16;
                for (int e = bxs * (NWAVES * 64) + tid; e < total; e += G * NWAVES * 64) {
                    const int g8 = e & 15, t = (e >> 4) % 22, rl = e / (16 * 22), r = row0 + rl;
                    const int L = r < ML ? SEQ : CTXL, pos = r < ML ? (r & (SEQ - 1)) : ((r - ML) & (CTXL - 1));
                    const int ch = 128 * t + 8 * g8;
                    const bf16_t* up = Ub + (size_t)rl * NUP + 256 * t + 8 * g8;
                    float ac[8], gc[8], am[8], gm[8], ap[8], gp[8];
                    unpack8(*(const u32x4*)up, ac); unpack8(*(const u32x4*)(up + 128), gc);
                    if (pos > 0) { unpack8(*(const u32x4*)(up - NUP), am); unpack8(*(const u32x4*)(up - NUP + 128), gm); } else {
#pragma unroll
                        for (int j = 0; j < 8; ++j) { am[j] = 0.f; gm[j] = 0.f; } }
                    if (pos < L - 1) { unpack8(*(const u32x4*)(up + NUP), ap); unpack8(*(const u32x4*)(up + NUP + 128), gp); } else {
#pragma unroll
                        for (int j = 0; j < 8; ++j) { ap[j] = 0.f; gp[j] = 0.f; } }
                    float o8[8];
#pragma unroll
                    for (int j = 0; j < 8; ++j) {
                        const float av = cw[ch + j] * am[j] + cw[NUP + ch + j] * ac[j] + cw[2 * NUP + ch + j] * ap[j] + cb[ch + j];
                        const float gv = cw[DFF + ch + j] * gm[j] + cw[NUP + DFF + ch + j] * gc[j] + cw[2 * NUP + DFF + ch + j] * gp[j] + cb[DFF + ch + j];
                        o8[j] = gv / (1.0f + expf(-gv)) * av; }
                    *(u32x4*)(ACT + (size_t)r * DFF + ch) = pack8((f32x4){o8[0], o8[1], o8[2], o8[3]}, (f32x4){o8[4], o8[5], o8[6], o8[7]});
                }
            }
        }
        else if (HAS(K_INCD) && kind == K_INCD) {
            pg8::Gemm g{A2, Wcd, MT, NCD, 1024}; pg8::StaticOrder S; S.init(MT, NCD, G, bxs);
            pg8::EpiCD E{Q2, K2, V2, PL, ssqB, bcd, ropec, ropes};
            pg8::gemm_phase<pg8::EpiCD, pg8::StaticOrder, true, true>(ldsl, g, S, E, tid);
        }
        else if (HAS(K_ATT1) && kind == K_ATT1) {
            for (int ui = vcu; ui < 1024; ui += G) { const int b = ui >> 6, qb = (ui >> 2) & 15, gq = ui & 3; att::win_unit(Q2, K2, V2, A1, b, qb, gq, sink_c, (char*)lds, tid); }
            for (int it = vcu; it < ML / 64; it += G) {
                for (int e = tid; e < 64 * 64; e += NWAVES * 64) { const int r = it * 64 + (e >> 6), c = (e & 63) * 8, gq = c >> 7, hw = 1 << gq;
                    const int pos = r & (SEQ - 1), rbase = r - pos; const int lo = pos - hw > 0 ? pos - hw : 0, hi = pos + hw < SEQ ? pos + hw : SEQ;
                    float s[8], t8[8];
#pragma unroll
                    for (int j = 0; j < 8; ++j) s[j] = 0.f;
                    for (int q = lo; q < hi; ++q) { unpack8(*(const u32x4*)(PL + (size_t)(rbase + q) * 512 + c), t8);
#pragma unroll
                        for (int j = 0; j < 8; ++j) s[j] += t8[j]; }
                    unpack8(*(const u32x4*)(PL + (size_t)r * 512 + c), t8); const float inv = 1.0f / (float)(hi - lo);
                    *(u32x4*)(A1 + (size_t)r * DM + 512 + c) = pack8((f32x4){s[0] * inv - t8[0], s[1] * inv - t8[1], s[2] * inv - t8[2], s[3] * inv - t8[3]},
                                                                      (f32x4){s[4] * inv - t8[4], s[5] * inv - t8[5], s[6] * inv - t8[6], s[7] * inv - t8[7]}); }
            }
        }
        else if (HAS(K_FINAL) && kind == K_FINAL) {
            for (int m = gw; m < ML; m += NGW) {
                const float rs = pg8::row_rs(ssqB, m);
                f32x4* xp = (f32x4*)(out + (size_t)m * DM) + lane; const f32x4* wp = (const f32x4*)fnw + lane;
#pragma unroll
                for (int j = 0; j < 4; ++j) xp[64 * j] = xp[64 * j] * rs * wp[64 * j];
            }
        }
        if (step + 1 < args.hi) { if (ONE_LAUNCH) xcd_barrier(bar); }
    }
}

extern "C" void kernel_launch(void* const* d_in, const int* in_sizes, int n_in, void* d_out, int out_size, void* d_ws, size_t ws_size, hipStream_t stream) {
    static int grid = 0;
    if (grid == 0) {
        if (n_in != 21 || in_sizes[0] != ML * DM || out_size != ML * DM || ws_size < WS_END) { fprintf(stderr, "kernel_launch: unexpected shapes (n_in %d, in0 %d, out %d, ws %zu < %zu)\n", n_in, n_in > 0 ? in_sizes[0] : -1, out_size, ws_size, (size_t)WS_END); grid = -1; return; }
        int dev = 0, cus = 0, per_cu = 0;
        if (hipGetDevice(&dev) != hipSuccess || hipDeviceGetAttribute(&cus, hipDeviceAttributeMultiprocessorCount, dev) != hipSuccess) { fprintf(stderr, "kernel_launch: device query failed\n"); grid = -1; return; }
        bool okattr = true;
#if ONE_LAUNCH
        okattr = hipFuncSetAttribute((const void*)fwd_kernel<-1>, hipFuncAttributeMaxDynamicSharedMemorySize, LDS_BYTES) == hipSuccess;
        if (hipOccupancyMaxActiveBlocksPerMultiprocessor(&per_cu, (const void*)fwd_kernel<-1>, NWAVES * 64, LDS_BYTES) != hipSuccess || per_cu < 1) fprintf(stderr, "kernel_launch: occupancy query reports %d\n", per_cu);
#else
        okattr = okattr && hipFuncSetAttribute((const void*)fwd_kernel<0>, hipFuncAttributeMaxDynamicSharedMemorySize, LDS_BYTES) == hipSuccess;
        okattr = okattr && hipFuncSetAttribute((const void*)fwd_kernel<1>, hipFuncAttributeMaxDynamicSharedMemorySize, LDS_BYTES) == hipSuccess;
        okattr = okattr && hipFuncSetAttribute((const void*)fwd_kernel<2>, hipFuncAttributeMaxDynamicSharedMemorySize, LDS_BYTES) == hipSuccess;
        okattr = okattr && hipFuncSetAttribute((const void*)fwd_kernel<3>, hipFuncAttributeMaxDynamicSharedMemorySize, LDS_BYTES) == hipSuccess;
        okattr = okattr && hipFuncSetAttribute((const void*)fwd_kernel<4>, hipFuncAttributeMaxDynamicSharedMemorySize, LDS_BYTES) == hipSuccess;
        okattr = okattr && hipFuncSetAttribute((const void*)fwd_kernel<5>, hipFuncAttributeMaxDynamicSharedMemorySize, LDS_BYTES) == hipSuccess;
        okattr = okattr && hipFuncSetAttribute((const void*)fwd_kernel<6>, hipFuncAttributeMaxDynamicSharedMemorySize, LDS_BYTES) == hipSuccess;
        okattr = okattr && hipFuncSetAttribute((const void*)fwd_kernel<7>, hipFuncAttributeMaxDynamicSharedMemorySize, LDS_BYTES) == hipSuccess;
        okattr = okattr && hipFuncSetAttribute((const void*)fwd_kernel<8>, hipFuncAttributeMaxDynamicSharedMemorySize, LDS_BYTES) == hipSuccess;
        okattr = okattr && hipFuncSetAttribute((const void*)fwd_kernel<9>, hipFuncAttributeMaxDynamicSharedMemorySize, LDS_BYTES) == hipSuccess;
        (void)per_cu;
#endif
        if (!okattr) { fprintf(stderr, "kernel_launch: hipFuncSetAttribute failed\n"); grid = -1; return; }
        (void)hipGetLastError();
        grid = cus;
    }
    if (grid < 0) return;
    (void)hipMemsetAsync((char*)d_ws + WS_CTL, 0, CTL_ZERO_BYTES, stream);
    Args a{};
    for (int i = 0; i < 21; ++i) a.in[i] = (const float*)d_in[i];
    a.out = (float*)d_out; a.ws = (unsigned char*)d_ws;
#if ONE_LAUNCH
    a.lo = 0; a.hi = N_STEPS;
    hipLaunchKernelGGL(fwd_kernel<-1>, dim3(grid), dim3(NWAVES * 64), LDS_BYTES, stream, a);
#else
    for (int s = 0; s < N_STEPS; ++s) { a.lo = s; a.hi = s + 1;
        switch (step_kind(s)) {
            case K_PREPA: hipLaunchKernelGGL(fwd_kernel<K_PREPA>, dim3(grid), dim3(NWAVES * 64), LDS_BYTES, stream, a); break;
            case K_PREPB: hipLaunchKernelGGL(fwd_kernel<K_PREPB>, dim3(grid), dim3(NWAVES * 64), LDS_BYTES, stream, a); break;
            case K_INAB: hipLaunchKernelGGL(fwd_kernel<K_INAB>, dim3(grid), dim3(NWAVES * 64), LDS_BYTES, stream, a); break;
            case K_ATT0: hipLaunchKernelGGL(fwd_kernel<K_ATT0>, dim3(grid), dim3(NWAVES * 64), LDS_BYTES, stream, a); break;
            case K_RES: hipLaunchKernelGGL(fwd_kernel<K_RES>, dim3(grid), dim3(NWAVES * 64), LDS_BYTES, stream, a); break;
            case K_UP: hipLaunchKernelGGL(fwd_kernel<K_UP>, dim3(grid), dim3(NWAVES * 64), LDS_BYTES, stream, a); break;
            case K_GATE: hipLaunchKernelGGL(fwd_kernel<K_GATE>, dim3(grid), dim3(NWAVES * 64), LDS_BYTES, stream, a); break;
            case K_INCD: hipLaunchKernelGGL(fwd_kernel<K_INCD>, dim3(grid), dim3(NWAVES * 64), LDS_BYTES, stream, a); break;
            case K_ATT1: hipLaunchKernelGGL(fwd_kernel<K_ATT1>, dim3(grid), dim3(NWAVES * 64), LDS_BYTES, stream, a); break;
            default: hipLaunchKernelGGL(fwd_kernel<K_FINAL>, dim3(grid), dim3(NWAVES * 64), LDS_BYTES, stream, a); break;
        }
    }
#endif
    const hipError_t le = hipPeekAtLastError();
    if (le != hipSuccess) fprintf(stderr, "kernel_launch: launch failed: %s\n", hipGetErrorName(le));
}
```

```cpp
#include <hip/hip_runtime.h>
#include <hip/hip_bf16.h>
#include <cstdio>
#include <cstdint>

#ifndef ONE_LAUNCH
#define ONE_LAUNCH 1
#endif

#define LAS __attribute__((address_space(3)))
#define GAS __attribute__((address_space(1)))
typedef unsigned short bf16_t;
typedef short bf16x8 __attribute__((ext_vector_type(8)));
typedef short s16x4 __attribute__((ext_vector_type(4)));
typedef float f32x4 __attribute__((ext_vector_type(4)));
typedef float f32x16 __attribute__((ext_vector_type(16)));
typedef unsigned u32x4 __attribute__((ext_vector_type(4)));
typedef unsigned u32x2 __attribute__((ext_vector_type(2)));

constexpr int DM = 1024, NB = 16, SEQ = 2048, CTXL = 256;
constexpr int ML = NB * SEQ, MC = NB * CTXL, MT = ML + MC;
constexpr int DFF = 2816, NUP = 2 * DFF, NAB = 3072, NCD = 1280;
constexpr float EPS = 1e-6f;
constexpr int NWAVES = 8;

constexpr size_t MiB = 1u << 20;
constexpr size_t WS_CTL = 0, CTL_ZERO_BYTES = 1 * MiB;
constexpr size_t WS_MODS = 1 * MiB;
constexpr size_t WS_BUP0 = 2 * MiB;
constexpr size_t WS_BUP1 = 2 * MiB + 512 * 1024;
constexpr size_t WS_BCD = 3 * MiB;
constexpr size_t WS_ROPEC = 3 * MiB + 256 * 1024;
constexpr size_t WS_ROPES = WS_ROPEC + 4096;
constexpr size_t WS_LAM = 3 * MiB + 512 * 1024;
constexpr size_t WS_WAB = 4 * MiB, WS_WOAB = 10 * MiB, WS_WCD = 12 * MiB, WS_WOCD = 15 * MiB, WS_WUP0 = 17 * MiB, WS_WUP1 = 28 * MiB, WS_WDN0 = 39 * MiB, WS_WDN1 = 45 * MiB;
constexpr size_t WS_XC = 51 * MiB;
constexpr size_t WS_SSQA = 67 * MiB, WS_SSQB = 70 * MiB;
constexpr size_t WS_A1 = 73 * MiB, WS_A2 = 145 * MiB;
constexpr size_t WS_R = 217 * MiB;
constexpr size_t WS_GB = WS_R, WS_P = WS_R + 36 * MiB, WS_Q = WS_R + 72 * MiB, WS_K = WS_R + 108 * MiB, WS_V = WS_R + 144 * MiB;
constexpr size_t WS_ACT = WS_R;
constexpr size_t WS_Q2 = WS_R, WS_PL = WS_R + 36 * MiB, WS_K2 = WS_R + 72 * MiB, WS_V2 = WS_R + 81 * MiB;
constexpr size_t WS_U = 415 * MiB;
constexpr size_t WS_JUNK = 430 * MiB;
constexpr size_t WS_END = 459 * MiB;
constexpr int CW_BAR = 4096;

__device__ __forceinline__ unsigned cvt_pk_bf16(float lo, float hi) { unsigned r; asm volatile("v_cvt_pk_bf16_f32 %0, %1, %2" : "=v"(r) : "v"(lo), "v"(hi)); return r; }
__device__ __forceinline__ u32x4 pack8(f32x4 a, f32x4 b) { u32x4 w; w.x = cvt_pk_bf16(a[0], a[1]); w.y = cvt_pk_bf16(a[2], a[3]); w.z = cvt_pk_bf16(b[0], b[1]); w.w = cvt_pk_bf16(b[2], b[3]); return w; }
__device__ __forceinline__ unsigned f2bf(float f) { unsigned u = __builtin_bit_cast(unsigned, f); return (u + 0x7fffu + ((u >> 16) & 1u)) >> 16; }
__device__ __forceinline__ float bflo(unsigned w) { return __builtin_bit_cast(float, w << 16); }
__device__ __forceinline__ float bfhi(unsigned w) { return __builtin_bit_cast(float, w & 0xffff0000u); }
__device__ __forceinline__ void unpack8(u32x4 w, float (&f)[8]) { f[0] = bflo(w.x); f[1] = bfhi(w.x); f[2] = bflo(w.y); f[3] = bfhi(w.y); f[4] = bflo(w.z); f[5] = bfhi(w.z); f[6] = bflo(w.w); f[7] = bfhi(w.w); }
__device__ __forceinline__ float wave_sum(float v) {
#pragma unroll
    for (int o = 1; o < 64; o <<= 1) v += __shfl_xor(v, o);
    return v;
}

namespace pg8 {
#define PG8_LAS __attribute__((address_space(3)))
constexpr int BM = 256, BK = 64, HALF = 128, HTB = HALF * BK * 2, STAGE_BYTES = 8 * HTB, NXCD = 8, WGM = 8;
__host__ __device__ __forceinline__ int lds_byte(int r, int c) { const int st = (r >> 4) * 2 + (c >> 5), rr = r & 15, cc = c & 31, ob = rr * 64 + cc * 2; return st * 1024 + (ob ^ (((ob >> 9) & 1) << 5)); }
__host__ __device__ __forceinline__ void stage_rc(int b, int& R, int& C) { const int st = b / 1024, sb = b % 1024, swz = sb ^ (((sb >> 9) & 1) << 5); R = (st >> 1) * 16 + swz / 64; C = (st & 1) * 32 + (swz % 64) / 2; }
__host__ __device__ __forceinline__ int perm32(int rho) { const int n = rho >> 4, i = rho & 15; return 8 * (i >> 2) + 4 * n + (i & 3); }
struct Unit { int pm, pn; };
struct Gemm { const bf16_t* A; const bf16_t* Bt; int M, N, K; };
struct StaticOrder {
    int nM, nN, nwg, G, c;
    __host__ __device__ void init(int M, int N, int G_, int c_) { nM = M / BM; nN = N / BM; nwg = nM * nN; G = G_; c = c_; }
    __host__ __device__ bool next(int i, Unit& u) const {
        const long L = (long)i * G + c; if (L >= nwg) return false;
        int wgid = (int)L; { const int q = nwg / NXCD, r = nwg % NXCD, xcd = wgid % NXCD, off = wgid / NXCD; wgid = (xcd < r ? xcd * (q + 1) : r * (q + 1) + (xcd - r) * q) + off; }
        const int nig = WGM * nN, gid = wgid / nig, fm = gid * WGM, gsz = (nM - fm) < WGM ? (nM - fm) : WGM;
        u.pm = fm + ((wgid % nig) % gsz); u.pn = (wgid % nig) / gsz; return true;
    }
    __device__ __forceinline__ void a_ready(const Unit&) const {}
    __device__ __forceinline__ void done(const Unit&) const {}
};
template <class Epi, class Sched, bool ALIGN_EPI = false, bool SP2 = false>
__device__ __forceinline__ void gemm_phase(PG8_LAS unsigned char* lds, const Gemm g, const Sched& S, const Epi& E, const int tid) {
    const int wid = __builtin_amdgcn_readfirstlane(tid >> 6), lane = tid & 63, wr = wid >> 2, wc = wid & 3, fr = lane & 15, fq = lane >> 4;
    const int K = g.K, nt = K / BK;
    unsigned voffA[2], voffB[2];
#pragma unroll
    for (int i = 0; i < 2; ++i) { int R, C; stage_rc(tid * 16 + i * 8192, R, C); const int Rb = Epi::PERM ? ((R & ~31) + perm32(R & 31)) : R;
        const int Ra = Epi::APERM ? ((R & ~63) | ((R & 15) << 2) | ((R >> 4) & 3)) : R;
        voffA[i] = (unsigned)(Ra * K + C) * 2u; voffB[i] = (unsigned)(Rb * K + C) * 2u; }
    const size_t kstep = (size_t)(BK * 2);
    const size_t hstep = (size_t)HALF * K * 2;
    const size_t tstep = 2 * hstep;
    const unsigned ldsw = (unsigned)wid * 1024u;
    const int aoff = lds_byte(wr * 64 + fr, fq * 8), boff = lds_byte(wc * 32 + fr, fq * 8);
#define PG8_SA(b, h) (((b) * 2 + (h)) * HTB)
#define PG8_SB(b, h) ((4 + (b) * 2 + (h)) * HTB)
#define PG8_STAGE(bufoff, gbase, voff) do { _Pragma("unroll") for (int _i = 0; _i < 2; ++_i) \
        __builtin_amdgcn_global_load_lds((const unsigned*)((const char*)(gbase) + (voff)[_i]), (PG8_LAS unsigned*)(lds + (bufoff) + ldsw + _i * 8192), 16, 0, 0); } while (0)
#define PG8_LDA(dst, b, h) do { _Pragma("unroll") for (int m = 0; m < 4; ++m) _Pragma("unroll") for (int k = 0; k < 2; ++k) dst[m][k] = *(const PG8_LAS bf16x8*)(lds + PG8_SA(b, h) + aoff + m * 2048 + k * 1024); } while (0)
#define PG8_LDB(dst, b, h) do { _Pragma("unroll") for (int n = 0; n < 2; ++n) _Pragma("unroll") for (int k = 0; k < 2; ++k) dst[n][k] = *(const PG8_LAS bf16x8*)(lds + PG8_SB(b, h) + boff + n * 2048 + k * 1024); } while (0)
#define PG8_MMA(ai, bj, At, Bt) do { __builtin_amdgcn_s_setprio(1); _Pragma("unroll") for (int m = 0; m < 4; ++m) _Pragma("unroll") for (int n = 0; n < 2; ++n) _Pragma("unroll") for (int k = 0; k < 2; ++k) \
        acc[ai][bj][m][n] = __builtin_amdgcn_mfma_f32_16x16x32_bf16(Bt[n][k], At[m][k], acc[ai][bj][m][n], 0, 0, 0); __builtin_amdgcn_s_setprio(0); } while (0)
#define PG8_WAIT_V(n) asm volatile("s_waitcnt vmcnt(" #n ")" ::: "memory")
#define PG8_WAIT_L(n) asm volatile("s_waitcnt lgkmcnt(" #n ")" ::: "memory")
#define PG8_BAR __builtin_amdgcn_s_barrier()
#define PG8_SCHED __builtin_amdgcn_sched_barrier(0)
    Unit cur, nxt; int ui = 0;
    if (!S.next(0, cur)) return;
    f32x4 acc[2][2][4][2];
#pragma unroll
    for (int a = 0; a < 2; ++a)
#pragma unroll
        for (int b = 0; b < 2; ++b)
#pragma unroll
            for (int m = 0; m < 4; ++m)
#pragma unroll
                for (int n = 0; n < 2; ++n) acc[a][b][m][n] = (f32x4){0.f, 0.f, 0.f, 0.f};
    bf16x8 At[4][2], B0[2][2], B1[2][2];
    const char* cA = (const char*)g.A + (size_t)cur.pm * tstep; const char* cB = (const char*)g.Bt + (size_t)cur.pn * tstep;
    S.a_ready(cur);
    if constexpr (SP2) {
        PG8_STAGE(PG8_SB(0, 0), cB, voffB); PG8_STAGE(PG8_SB(0, 1), cB + hstep, voffB); PG8_STAGE(PG8_SA(0, 0), cA, voffA); PG8_STAGE(PG8_SA(0, 1), cA + hstep, voffA);
        if (wr == 1) PG8_BAR;
        PG8_WAIT_V(2); PG8_BAR;
        PG8_STAGE(PG8_SB(1, 0), cB + kstep, voffB); PG8_STAGE(PG8_SA(1, 0), cA + kstep, voffA); PG8_STAGE(PG8_SB(1, 1), cB + hstep + kstep, voffB);
        PG8_WAIT_V(6); PG8_BAR;
    } else {
        PG8_STAGE(PG8_SB(0, 0), cB, voffB); PG8_STAGE(PG8_SA(0, 0), cA, voffA); PG8_STAGE(PG8_SB(0, 1), cB + hstep, voffB); PG8_STAGE(PG8_SA(0, 1), cA + hstep, voffA);
        if (wr == 1) PG8_BAR;
        PG8_WAIT_V(4); PG8_BAR;
        PG8_STAGE(PG8_SB(1, 0), cB + kstep, voffB); PG8_STAGE(PG8_SA(1, 0), cA + kstep, voffA); PG8_STAGE(PG8_SB(1, 1), cB + hstep + kstep, voffB);
        PG8_WAIT_V(6); PG8_BAR;
    }
    for (;;) {
        const bool has_next = S.next(ui + 1, nxt);
        const char* nA = has_next ? (const char*)g.A + (size_t)nxt.pm * tstep : cA; const char* nB = has_next ? (const char*)g.Bt + (size_t)nxt.pn * tstep : cB;
        for (int t = 0; t < nt; t += 2) {
            const bool last = (t == nt - 2);
            const char* a1 = cA + (size_t)(t + 1) * kstep;
            const char* a2 = last ? nA : cA + (size_t)(t + 2) * kstep; const char* b2 = last ? nB : cB + (size_t)(t + 2) * kstep;
            const char* a3 = a2 + kstep; const char* b3 = b2 + kstep;
            if (last && has_next) S.a_ready(nxt);
            if constexpr (SP2) {
            PG8_LDB(B0, 0, 0); PG8_LDB(B1, 0, 1); PG8_SCHED; PG8_LDA(At, 0, 0); PG8_STAGE(PG8_SA(1, 1), a1 + hstep, voffA);
            PG8_WAIT_V(8); PG8_WAIT_L(0); PG8_BAR; PG8_MMA(0, 0, At, B0); PG8_MMA(0, 1, At, B1); PG8_BAR; PG8_SCHED;
            PG8_LDA(At, 0, 1); PG8_STAGE(PG8_SB(0, 0), b2, voffB); PG8_STAGE(PG8_SB(0, 1), b2 + hstep, voffB); PG8_STAGE(PG8_SA(0, 0), a2, voffA);
            PG8_WAIT_V(8); PG8_WAIT_L(0); PG8_BAR; PG8_MMA(1, 0, At, B0); PG8_MMA(1, 1, At, B1); PG8_BAR; PG8_SCHED;
            PG8_LDB(B0, 1, 0); PG8_LDB(B1, 1, 1); PG8_SCHED; PG8_LDA(At, 1, 0); PG8_STAGE(PG8_SA(0, 1), a2 + hstep, voffA);
            PG8_WAIT_V(8); PG8_WAIT_L(0); PG8_BAR; PG8_MMA(0, 0, At, B0); PG8_MMA(0, 1, At, B1); PG8_BAR; PG8_SCHED;
            PG8_LDA(At, 1, 1); PG8_STAGE(PG8_SB(1, 0), b3, voffB); PG8_STAGE(PG8_SB(1, 1), b3 + hstep, voffB); PG8_STAGE(PG8_SA(1, 0), a3, voffA);
            PG8_WAIT_V(8); PG8_WAIT_L(0); PG8_BAR; PG8_MMA(1, 0, At, B0); PG8_MMA(1, 1, At, B1); PG8_BAR; PG8_SCHED;
            } else {
            PG8_LDB(B0, 0, 0); PG8_SCHED; PG8_LDA(At, 0, 0); PG8_STAGE(PG8_SA(1, 1), a1 + hstep, voffA);
            PG8_WAIT_L(8); PG8_BAR; PG8_WAIT_L(0); PG8_MMA(0, 0, At, B0); PG8_BAR; PG8_SCHED;
            PG8_LDB(B1, 0, 1); PG8_STAGE(PG8_SB(0, 0), b2, voffB);
            PG8_BAR; PG8_WAIT_L(0); PG8_MMA(0, 1, At, B1); PG8_BAR;
            PG8_LDA(At, 0, 1); PG8_STAGE(PG8_SA(0, 0), a2, voffA);
            PG8_BAR; PG8_WAIT_L(0); PG8_MMA(1, 0, At, B0); PG8_BAR; PG8_SCHED;
            PG8_STAGE(PG8_SB(0, 1), b2 + hstep, voffB);
            PG8_WAIT_V(6); PG8_BAR; PG8_MMA(1, 1, At, B1); PG8_BAR;
            PG8_LDB(B0, 1, 0); PG8_SCHED; PG8_LDA(At, 1, 0); PG8_STAGE(PG8_SA(0, 1), a2 + hstep, voffA);
            PG8_WAIT_L(8); PG8_BAR; PG8_WAIT_L(0); PG8_MMA(0, 0, At, B0); PG8_BAR; PG8_SCHED;
            PG8_LDB(B1, 1, 1); PG8_STAGE(PG8_SB(1, 0), b3, voffB);
            PG8_BAR; PG8_WAIT_L(0); PG8_MMA(0, 1, At, B1); PG8_BAR;
            PG8_LDA(At, 1, 1); PG8_STAGE(PG8_SA(1, 0), a3, voffA);
            PG8_BAR; PG8_WAIT_L(0); PG8_MMA(1, 0, At, B0); PG8_BAR; PG8_SCHED;
            PG8_STAGE(PG8_SB(1, 1), b3 + hstep, voffB);
            PG8_WAIT_V(6); PG8_BAR; PG8_MMA(1, 1, At, B1); PG8_BAR;
            }
        }
        if constexpr (ALIGN_EPI) { if (wr == 0) PG8_BAR; }
        E(acc, cur, wr, wc, fr, fq); S.done(cur);
        if (!has_next) break;
#pragma unroll
        for (int a = 0; a < 2; ++a)
#pragma unroll
            for (int b = 0; b < 2; ++b)
#pragma unroll
                for (int m = 0; m < 4; ++m)
#pragma unroll
                    for (int n = 0; n < 2; ++n) acc[a][b][m][n] = (f32x4){0.f, 0.f, 0.f, 0.f};
        cur = nxt; cA = nA; cB = nB; ++ui;
        if constexpr (ALIGN_EPI) { if (wr == 1) PG8_BAR; }
    }
    PG8_WAIT_V(0);
    if constexpr (!ALIGN_EPI) { if (wr == 0) PG8_BAR; }
    PG8_BAR;
#undef PG8_SA
#undef PG8_SB
#undef PG8_STAGE
#undef PG8_LDA
#undef PG8_LDB
#undef PG8_MMA
#undef PG8_WAIT_V
#undef PG8_WAIT_L
#undef PG8_BAR
#undef PG8_SCHED
}

typedef f32x4 (&AccRef)[2][2][4][2];

struct EpiAB {
    static constexpr bool PERM = true, APERM = false;
    bf16_t *GB, *P, *Q, *K, *V; const float *ropec, *ropes;
    __device__ __forceinline__ void operator()(AccRef acc, const Unit& u, int wr, int wc, int fr, int fq) const {
        const int pn = u.pn, rb = u.pm * BM + wr * 64 + fr, cl = wc * 32 + 8 * fq;
        if (pn < 4) {
#pragma unroll
            for (int ai = 0; ai < 2; ++ai)
#pragma unroll
                for (int m = 0; m < 4; ++m) { const size_t r = (size_t)(rb + ai * HALF + m * 16);
                    *(u32x4*)(P + r * 512 + pn * 128 + cl) = pack8(acc[ai][0][m][0] * acc[ai][1][m][0], acc[ai][0][m][1] * acc[ai][1][m][1]); }
        } else if (pn < 6) {
#pragma unroll
            for (int ai = 0; ai < 2; ++ai)
#pragma unroll
                for (int m = 0; m < 4; ++m) { const size_t r = (size_t)(rb + ai * HALF + m * 16);
#pragma unroll
                    for (int bj = 0; bj < 2; ++bj) *(u32x4*)(GB + r * 512 + (pn - 4) * 256 + bj * HALF + cl) = pack8(acc[ai][bj][m][0], acc[ai][bj][m][1]); }
        } else if (pn < 10) {
            bf16_t* dst = pn < 8 ? Q : K; const int hm = 4 * ((pn - 6) & 1) + wc, half = fq >> 1, i0 = 8 * (fq & 1);
            const bool latent = u.pm < ML / BM;
#pragma unroll
            for (int ai = 0; ai < 2; ++ai)
#pragma unroll
                for (int m = 0; m < 4; ++m) { const int r = rb + ai * HALF + m * 16;
                    f32x4 c0 = (f32x4){1.f, 1.f, 1.f, 1.f}, c1 = c0, s0 = (f32x4){0.f, 0.f, 0.f, 0.f}, s1 = s0;
                    if (latent) { const int tpos = r & (SEQ - 1), pos = half ? (tpos & 63) : (tpos >> 6);
                        c0 = *(const f32x4*)(ropec + pos * 16 + i0); c1 = *(const f32x4*)(ropec + pos * 16 + i0 + 4);
                        s0 = *(const f32x4*)(ropes + pos * 16 + i0); s1 = *(const f32x4*)(ropes + pos * 16 + i0 + 4); }
                    const f32x4 x1a = acc[ai][0][m][0], x1b = acc[ai][0][m][1], x2a = acc[ai][1][m][0], x2b = acc[ai][1][m][1];
                    bf16_t* bp = dst + (size_t)r * 512 + hm * 64 + half * 32 + i0;
                    *(u32x4*)bp = pack8(x1a * c0 - x2a * s0, x1b * c1 - x2b * s1);
                    *(u32x4*)(bp + 16) = pack8(x1a * s0 + x2a * c0, x1b * s1 + x2b * c1);
                    asm volatile("" ::: "memory"); }
        } else {
#pragma unroll
            for (int ai = 0; ai < 2; ++ai)
#pragma unroll
                for (int m = 0; m < 4; ++m) { const size_t r = (size_t)(rb + ai * HALF + m * 16);
#pragma unroll
                    for (int bj = 0; bj < 2; ++bj) *(u32x4*)(V + r * 512 + (pn - 10) * 256 + bj * HALF + cl) = pack8(acc[ai][bj][m][0], acc[ai][bj][m][1]); }
        }
    }
};

struct EpiRes {
    static constexpr bool PERM = true, APERM = false;
    const float *xin_lat, *xin_ctx; float *xout_lat, *xout_ctx; bf16_t* Aout; const float* gate; const float* scl; float* ssq; bool has_a;
    __device__ __forceinline__ void operator()(AccRef acc, const Unit& u, int wr, int wc, int fr, int fq) const {
        const bool latent = u.pm < ML / BM; const int bvec = latent ? (u.pm >> 3) : 16;
        const float* xin = latent ? xin_lat : xin_ctx; float* xout = latent ? xout_lat : xout_ctx;
        const int rb = u.pm * BM + wr * 64 + fr, rsub = latent ? 0 : ML, col0 = u.pn * BM + wc * 32 + 8 * fq;
        f32x4 g[2][2], sc[2][2];
#pragma unroll
        for (int bj = 0; bj < 2; ++bj)
#pragma unroll
            for (int n = 0; n < 2; ++n) { g[bj][n] = *(const f32x4*)(gate + (size_t)bvec * 6144 + col0 + bj * HALF + 4 * n);
                sc[bj][n] = *(const f32x4*)(scl + (size_t)bvec * 6144 + col0 + bj * HALF + 4 * n) + 1.0f; }
#pragma unroll
        for (int ai = 0; ai < 2; ++ai)
#pragma unroll
            for (int m = 0; m < 4; ++m) { const int r = rb + ai * HALF + m * 16; const size_t xo_off = (size_t)(r - rsub) * DM + col0; float ss = 0.f;
#pragma unroll
                for (int bj = 0; bj < 2; ++bj) { f32x4 xo[2];
#pragma unroll
                    for (int n = 0; n < 2; ++n) { const f32x4 xi = *(const f32x4*)(xin + xo_off + bj * HALF + 4 * n); xo[n] = xi + g[bj][n] * acc[ai][bj][m][n];
                        *(f32x4*)(xout + xo_off + bj * HALF + 4 * n) = xo[n]; ss += (xo[n][0] * xo[n][0] + xo[n][1] * xo[n][1]) + (xo[n][2] * xo[n][2] + xo[n][3] * xo[n][3]); }
                    if (has_a) *(u32x4*)(Aout + (size_t)r * DM + col0 + bj * HALF) = pack8(xo[0] * sc[bj][0], xo[1] * sc[bj][1]); }
                ss += __shfl_xor(ss, 16); ss += __shfl_xor(ss, 32);
                if (fq == 0) ssq[(size_t)r * 16 + u.pn * 4 + wc] = ss; }
    }
};

__device__ __forceinline__ float row_rs(const float* ssq, int r) {
    const f32x4* sp = (const f32x4*)(ssq + (size_t)r * 16); const f32x4 a = sp[0], b = sp[1], c = sp[2], d = sp[3];
    const float s = ((a[0] + a[1]) + (a[2] + a[3])) + ((b[0] + b[1]) + (b[2] + b[3])) + ((c[0] + c[1]) + (c[2] + c[3])) + ((d[0] + d[1]) + (d[2] + d[3]));
    return 1.0f / sqrtf(s * (1.0f / DM) + EPS);
}

__device__ __forceinline__ float dpp_shr1(float old, float src) { return __builtin_bit_cast(float, __builtin_amdgcn_update_dpp(__builtin_bit_cast(int, old), __builtin_bit_cast(int, src), 0x111, 0xf, 0xf, false)); }
__device__ __forceinline__ float dpp_shl1(float old, float src) { return __builtin_bit_cast(float, __builtin_amdgcn_update_dpp(__builtin_bit_cast(int, old), __builtin_bit_cast(int, src), 0x101, 0xf, 0xf, false)); }
struct EpiUpF {
    static constexpr bool PERM = true, APERM = true;
    bf16_t* ACT; const float* ssq; const float* bias; const float* cw; const float* cb; float* EDGE; PG8_LAS float* xch; bf16_t* JUNK;
    __device__ __forceinline__ void operator()(AccRef acc, const Unit& u, int wr, int wc, int fr, int fq) const {
        asm volatile("" : "+v"(fr), "+v"(fq));
        const int row_t0 = u.pm * BM, bvec = row_t0 < ML ? (row_t0 >> 11) : 16, wid = wr * 4 + wc;
#define UPF_COLG (u.pn * BM + wc * 32 + 8 * fq)
#define UPF_CHAN (u.pn * 128 + wc * 32 + 8 * fq)
        float rsv[2][4];
#pragma unroll
        for (int ai = 0; ai < 2; ++ai)
#pragma unroll
            for (int m = 0; m < 4; ++m) { const f32x4 p = *(const f32x4*)(ssq + (size_t)(row_t0 + ai * HALF + wr * 64 + 4 * fr + m) * 16 + 4 * fq); float sp = (p[0] + p[1]) + (p[2] + p[3]);
                sp += __shfl_xor(sp, 16); sp += __shfl_xor(sp, 32); rsv[ai][m] = __builtin_amdgcn_rsqf(sp * (1.0f / DM) + EPS); }
        asm volatile("" ::: "memory"); __builtin_amdgcn_sched_barrier(0);
#pragma unroll
        for (int bj = 0; bj < 2; ++bj)
#pragma unroll
            for (int n = 0; n < 2; ++n) { const f32x4 bv = *(const f32x4*)(bias + (size_t)bvec * NUP + UPF_COLG + bj * HALF + 4 * n);
#pragma unroll
                for (int ai = 0; ai < 2; ++ai)
#pragma unroll
                    for (int m = 0; m < 4; ++m) acc[ai][bj][m][n] = acc[ai][bj][m][n] * rsv[ai][m] + bv; }
        if (fr == 0) {
#pragma unroll
            for (int ai = 0; ai < 2; ++ai)
#pragma unroll
                for (int bj = 0; bj < 2; ++bj)
#pragma unroll
                    for (int n = 0; n < 2; ++n) *(PG8_LAS f32x4*)(xch + ((wid * 2 + ai) * 2 + 0) * 64 + bj * 32 + 8 * fq + 4 * n) = acc[ai][bj][0][n];
            if (wr == 0) {
#pragma unroll
                for (int bj = 0; bj < 2; ++bj)
#pragma unroll
                    for (int n = 0; n < 2; ++n) { *(f32x4*)(EDGE + (size_t)(u.pm * 4 + 0) * NUP + UPF_COLG + bj * HALF + 4 * n) = acc[0][bj][0][n];
                        *(f32x4*)(EDGE + (size_t)(u.pm * 4 + 1) * NUP + UPF_COLG + bj * HALF + 4 * n) = acc[0][bj][1][n]; }
            }
        }
        if (fr == 15) {
#pragma unroll
            for (int ai = 0; ai < 2; ++ai)
#pragma unroll
                for (int bj = 0; bj < 2; ++bj)
#pragma unroll
                    for (int n = 0; n < 2; ++n) *(PG8_LAS f32x4*)(xch + ((wid * 2 + ai) * 2 + 1) * 64 + bj * 32 + 8 * fq + 4 * n) = acc[ai][bj][3][n];
            if (wr == 1) {
#pragma unroll
                for (int bj = 0; bj < 2; ++bj)
#pragma unroll
                    for (int n = 0; n < 2; ++n) { *(f32x4*)(EDGE + (size_t)(u.pm * 4 + 2) * NUP + UPF_COLG + bj * HALF + 4 * n) = acc[1][bj][2][n];
                        *(f32x4*)(EDGE + (size_t)(u.pm * 4 + 3) * NUP + UPF_COLG + bj * HALF + 4 * n) = acc[1][bj][3][n]; }
            }
        }
        asm volatile("s_waitcnt lgkmcnt(0)" ::: "memory"); __builtin_amdgcn_s_barrier(); asm volatile("" ::: "memory"); __builtin_amdgcn_sched_barrier(0);
        asm volatile("" : "+v"(fr), "+v"(fq));
        const f32x4 zero4 = (f32x4){0.f, 0.f, 0.f, 0.f};
#pragma unroll
        for (int n = 0; n < 2; ++n) {
#pragma unroll
            for (int bj = 0; bj < 2; ++bj) {
                const int ch = bj * DFF + UPF_CHAN + 4 * n;
                const f32x4 w0 = *(const f32x4*)(cw + ch), w1 = *(const f32x4*)(cw + NUP + ch), w2 = *(const f32x4*)(cw + 2 * NUP + ch), cbv = *(const f32x4*)(cb + ch);
#pragma unroll
                for (int ai = 0; ai < 2; ++ai) {
                    const int xo = bj * 32 + 8 * fq + 4 * n;
                    const int pidx = wr ? ((wc * 2 + ai) * 2 + 1) : (((4 + wc) * 2 + 0) * 2 + 1), nidx = wr ? ((wc * 2 + 1) * 2 + 0) : (((4 + wc) * 2 + ai) * 2 + 0);
                    const bool pok = (wr == 1) || (ai == 1), nok = (wr == 0) || (ai == 0);
                    f32x4 pv = *(const PG8_LAS f32x4*)(xch + pidx * 64 + xo), nv = *(const PG8_LAS f32x4*)(xch + nidx * 64 + xo);
                    pv = pok ? pv : zero4; nv = nok ? nv : zero4;
                    const f32x4 v0 = acc[ai][bj][0][n], v1 = acc[ai][bj][1][n], v2 = acc[ai][bj][2][n], v3 = acc[ai][bj][3][n];
                    f32x4 up0, dn3;
#pragma unroll
                    for (int j = 0; j < 4; ++j) { up0[j] = dpp_shr1(pv[j], v3[j]); dn3[j] = dpp_shl1(nv[j], v0[j]); }
                    acc[ai][bj][0][n] = w0 * up0 + w1 * v0 + w2 * v1 + cbv;
                    acc[ai][bj][1][n] = w0 * v0 + w1 * v1 + w2 * v2 + cbv;
                    acc[ai][bj][2][n] = w0 * v1 + w1 * v2 + w2 * v3 + cbv;
                    acc[ai][bj][3][n] = w0 * v2 + w1 * v3 + w2 * dn3 + cbv;
                }
                asm volatile("" ::: "memory"); __builtin_amdgcn_sched_barrier(0);
            }
#pragma unroll
            for (int ai = 0; ai < 2; ++ai)
#pragma unroll
                for (int m = 0; m < 4; ++m) { const f32x4 a = acc[ai][0][m][n], gv = acc[ai][1][m][n]; f32x4 o;
#pragma unroll
                    for (int j = 0; j < 4; ++j) o[j] = a[j] * gv[j] * __builtin_amdgcn_rcpf(1.0f + __builtin_amdgcn_exp2f(-1.4426950408889634f * gv[j]));
                    acc[ai][0][m][n] = o; }
            __builtin_amdgcn_sched_barrier(0);
        }
        asm volatile("" : "+v"(fr), "+v"(fq));
#pragma unroll
        for (int ai = 0; ai < 2; ++ai)
#pragma unroll
            for (int m = 0; m < 4; ++m) { const size_t r = (size_t)(row_t0 + ai * HALF + wr * 64 + 4 * fr + m);
                bf16_t* dst = ACT + r * DFF;
                if (ai == 0 && m == 0) dst = (wr == 0 && fr == 0) ? JUNK + (size_t)(u.pm * 2 + 0) * DFF : dst;
                if (ai == 1 && m == 3) dst = (wr == 1 && fr == 15) ? JUNK + (size_t)(u.pm * 2 + 1) * DFF : dst;
                *(u32x4*)(dst + UPF_CHAN) = pack8(acc[ai][0][m][0], acc[ai][0][m][1]); }
    }
};
#undef UPF_COLG
#undef UPF_CHAN

struct EpiCD {
    static constexpr bool PERM = true, APERM = false;
    bf16_t *Q2, *K2, *V2, *PL; const float *ssq, *bias, *ropec, *ropes;
    __device__ __forceinline__ void operator()(AccRef acc, const Unit& u, int wr, int wc, int fr, int fq) const {
        const int pn = u.pn; const bool latent = u.pm < ML / BM; const int bvec = latent ? (u.pm >> 3) : 16;
        if (!latent && pn != 2) return;
        const int rb = u.pm * BM + wr * 64 + fr, col0 = pn * BM + wc * 32 + 8 * fq;
        f32x4 bv[2][2];
#pragma unroll
        for (int bj = 0; bj < 2; ++bj)
#pragma unroll
            for (int n = 0; n < 2; ++n) bv[bj][n] = *(const f32x4*)(bias + (size_t)bvec * NCD + col0 + bj * HALF + 4 * n);
        const int half = fq >> 1, i0 = 8 * (fq & 1);
#pragma unroll
        for (int ai = 0; ai < 2; ++ai)
#pragma unroll
            for (int m = 0; m < 4; ++m) { const int r = rb + ai * HALF + m * 16; const float rs = row_rs(ssq, r);
                const f32x4 v00 = acc[ai][0][m][0] * rs + bv[0][0], v01 = acc[ai][0][m][1] * rs + bv[0][1], v10 = acc[ai][1][m][0] * rs + bv[1][0], v11 = acc[ai][1][m][1] * rs + bv[1][1];
                if (pn < 2 || (pn == 2 && wc < 2)) {
                    f32x4 c0 = (f32x4){1.f, 1.f, 1.f, 1.f}, c1 = c0, s0 = (f32x4){0.f, 0.f, 0.f, 0.f}, s1 = s0;
                    if (latent) { const int tpos = r & (SEQ - 1), pos = half ? (tpos & 63) : (tpos >> 6);
                        c0 = *(const f32x4*)(ropec + pos * 16 + i0); c1 = *(const f32x4*)(ropec + pos * 16 + i0 + 4);
                        s0 = *(const f32x4*)(ropes + pos * 16 + i0); s1 = *(const f32x4*)(ropes + pos * 16 + i0 + 4); }
                    bf16_t* bp = (pn < 2) ? Q2 + (size_t)r * 512 + (4 * pn + wc) * 64 + half * 32 + i0 : K2 + (size_t)r * 128 + wc * 64 + half * 32 + i0;
                    *(u32x4*)bp = pack8(v00 * c0 - v10 * s0, v01 * c1 - v11 * s1);
                    *(u32x4*)(bp + 16) = pack8(v00 * s0 + v10 * c0, v01 * s1 + v11 * c1);
                } else if (pn == 2) {
                    bf16_t* bp = V2 + (size_t)r * 128 + (wc - 2) * 32 + 8 * fq;
                    *(u32x4*)bp = pack8(v00, v01); *(u32x4*)(bp + 64) = pack8(v10, v11);
                } else {
                    bf16_t* bp = PL + (size_t)r * 512 + (pn - 3) * 256 + wc * 32 + 8 * fq;
                    *(u32x4*)bp = pack8(v00, v01); *(u32x4*)(bp + HALF) = pack8(v10, v11);
                }
                asm volatile("" ::: "memory");
            }
    }
};
}

__device__ __forceinline__ int colmap_ab(int n) {
    const int t = n >> 8, c = n & 255;
    if (t < 4) return ((c >> 7) ? 1024 : 512) + 128 * t + (c & 127);
    if (t < 6) return 256 * (t - 4) + c;
    if (t < 10) { const int base = t < 8 ? 1536 : 2048, tt = (t - 6) & 1, bj = c >> 7, w = (c >> 5) & 3, half = (c >> 4) & 1, i = c & 15; return base + (4 * tt + w) * 64 + half * 32 + bj * 16 + i; }
    return 2560 + 256 * (t - 10) + c;
}
__device__ __forceinline__ int colmap_cd(int n) {
    const int t = n >> 8, c = n & 255, bj = c >> 7, w = (c >> 5) & 3;
    if (t < 2) { const int half = (c >> 4) & 1, i = c & 15; return (4 * t + w) * 64 + half * 32 + bj * 16 + i; }
    if (t == 2) { const int rest = c & 31; if (w < 2) return 512 + w * 64 + (rest >> 4) * 32 + bj * 16 + (rest & 15); return 640 + bj * 64 + (w - 2) * 32 + rest; }
    return 768 + 256 * (t - 3) + c;
}
__device__ __forceinline__ int colmap_up(int n) { const int t = n >> 8, c = n & 255; return (c >> 7) * DFF + 128 * t + (c & 127); }

namespace att {
constexpr int QBLK = 32, KVBLK = 64;
constexpr int SHM_V = KVBLK * 128 * 2, SHM_K = KVBLK * 128 * 2;
constexpr int OFF_V = 0, OFF_K = 2 * SHM_V, OFF_WS = 2 * SHM_V + 2 * SHM_K, OFF_STG = 73728, STG_LD = 132;
constexpr float SCALE = 0.125f, THR = 8.f;
#define KSWZ(row, colB) ((row) * 256 + ((colB) ^ (((row) & 7) << 4)))
#define SBAR() __builtin_amdgcn_sched_barrier(0)
__device__ __forceinline__ int crow(int r, int hi) { return (r & 3) + 8 * (r >> 2) + 4 * hi; }
__device__ __forceinline__ unsigned cvtpk(float lo, float hi) { unsigned r; asm volatile("v_cvt_pk_bf16_f32 %0, %1, %2" : "=v"(r) : "v"(lo), "v"(hi)); return r; }

__device__ __forceinline__ void partialSM(f32x16& p0, f32x16& p1, float& m_reg, float& mn, float& alpha) {
  constexpr float C = SCALE * 1.4426950408889634f;
  float pmax = p0[0];
#pragma unroll
  for (int r = 1; r < 16; ++r) pmax = fmaxf(pmax, p0[r]);
#pragma unroll
  for (int r = 0; r < 16; ++r) pmax = fmaxf(pmax, p1[r]);
  { auto rr = __builtin_amdgcn_permlane32_swap(__float_as_uint(pmax), __float_as_uint(pmax), false, false);
    pmax = fmaxf(__uint_as_float(rr[0]), __uint_as_float(rr[1])); }
  if (__builtin_expect(__all(pmax - m_reg <= THR / SCALE), 1)) { mn = m_reg; alpha = 1.f; }
  else { mn = fmaxf(m_reg, pmax); alpha = __builtin_amdgcn_exp2f((m_reg - mn) * C); m_reg = mn; }
  float mnC = -mn * C;
#pragma unroll
  for (int r = 0; r < 16; ++r) p0[r] = fmaf(p0[r], C, mnC);
#pragma unroll
  for (int r = 0; r < 16; ++r) p1[r] = fmaf(p1[r], C, mnC);
#pragma unroll
  for (int r = 0; r < 16; ++r) p0[r] = __builtin_amdgcn_exp2f(p0[r]);
}
__device__ __forceinline__ void finishSM(f32x16& p0, f32x16& p1, float alpha, float& l_reg, bf16x8& pa0, bf16x8& pa1, bf16x8& pa2, bf16x8& pa3) {
#pragma unroll
  for (int r = 0; r < 16; ++r) p1[r] = __builtin_amdgcn_exp2f(p1[r]);
  float ps = 0;
#pragma unroll
  for (int r = 0; r < 16; ++r) ps += p0[r];
#pragma unroll
  for (int r = 0; r < 16; ++r) ps += p1[r];
  { auto rr = __builtin_amdgcn_permlane32_swap(__float_as_uint(ps), __float_as_uint(ps), false, false);
    ps = __uint_as_float(rr[0]) + __uint_as_float(rr[1]); }
  l_reg = l_reg * alpha + ps;
#define PK4(P, BASE, OUT) do { unsigned a0 = cvtpk(P[BASE + 0], P[BASE + 1]), a1 = cvtpk(P[BASE + 2], P[BASE + 3]);   \
    unsigned b0 = cvtpk(P[BASE + 4], P[BASE + 5]), b1 = cvtpk(P[BASE + 6], P[BASE + 7]);                              \
    auto r0 = __builtin_amdgcn_permlane32_swap(a0, b0, false, false); auto r1 = __builtin_amdgcn_permlane32_swap(a1, b1, false, false); \
    u32x4 w = {r0[0], r1[0], r0[1], r1[1]}; OUT = *reinterpret_cast<bf16x8*>(&w); } while (0)
  PK4(p0, 0, pa0); PK4(p0, 8, pa1); PK4(p1, 0, pa2); PK4(p1, 8, pa3);
#undef PK4
}
__device__ __forceinline__ void qkt(f32x16& p0, f32x16& p1, const char* Ks, const bf16x8* qr, int r32, int hi, int coff) {
  p0 = f32x16{}; p1 = f32x16{};
#pragma unroll
  for (int d0 = 0; d0 < 4; ++d0) { int cb = (coff + d0 * 16 + hi * 8) * 2;
    bf16x8 b0 = *reinterpret_cast<const bf16x8*>(Ks + KSWZ(r32, cb));
    bf16x8 b1 = *reinterpret_cast<const bf16x8*>(Ks + KSWZ(32 + r32, cb));
    p0 = __builtin_amdgcn_mfma_f32_32x32x16_bf16(b0, qr[d0], p0, 0, 0, 0);
    p1 = __builtin_amdgcn_mfma_f32_32x32x16_bf16(b1, qr[d0], p1, 0, 0, 0); }
}
__device__ __forceinline__ int v_st(int k, int c) { const int kk = (k & ~0xC) | ((k & 4) << 1) | ((k & 8) >> 1); return ((kk >> 3) * 4 + (c >> 5)) * 512 + ((kk & 7) * 32 + (c & 31)) * 2; }
__device__ __forceinline__ int v_rd_base(int lane) { return ((lane & 3) << 3) | (((lane >> 2) & 3) << 6) | (((lane >> 4) & 1) << 5) | (((lane >> 5) & 1) << 8); }
constexpr int v_rd_off(int d0, int ks, int half) { return d0 * 512 + ks * 4096 + half * 2048; }
template <int OFF> __device__ __forceinline__ s16x4 tr_read(int vb) {
  s16x4 r; asm volatile("ds_read_b64_tr_b16 %0, %1 offset:%2" : "=&v"(r) : "v"(vb), "i"(OFF) : "memory"); return r;
}
template <int D0> __device__ __forceinline__ void pv_one(f32x16& od, int vb, bf16x8 pa0, bf16x8 pa1, bf16x8 pa2, bf16x8 pa3) {
  const s16x4 l0 = tr_read<v_rd_off(D0, 0, 0)>(vb), h0 = tr_read<v_rd_off(D0, 0, 1)>(vb), l1 = tr_read<v_rd_off(D0, 1, 0)>(vb), h1 = tr_read<v_rd_off(D0, 1, 1)>(vb);
  const s16x4 l2 = tr_read<v_rd_off(D0, 2, 0)>(vb), h2 = tr_read<v_rd_off(D0, 2, 1)>(vb), l3 = tr_read<v_rd_off(D0, 3, 0)>(vb), h3 = tr_read<v_rd_off(D0, 3, 1)>(vb);
  asm volatile("s_waitcnt lgkmcnt(0)" ::: "memory"); SBAR();
#define PK(L, H) (bf16x8){L[0], L[1], L[2], L[3], H[0], H[1], H[2], H[3]}
  od = __builtin_amdgcn_mfma_f32_32x32x16_bf16(pa0, PK(l0, h0), od, 0, 0, 0);
  od = __builtin_amdgcn_mfma_f32_32x32x16_bf16(pa1, PK(l1, h1), od, 0, 0, 0);
  od = __builtin_amdgcn_mfma_f32_32x32x16_bf16(pa2, PK(l2, h2), od, 0, 0, 0);
  od = __builtin_amdgcn_mfma_f32_32x32x16_bf16(pa3, PK(l3, h3), od, 0, 0, 0);
#undef PK
}
template <int MODE> __device__ __forceinline__ void pv_all(f32x16* o, int vb, int kvh, bf16x8 pa0, bf16x8 pa1, bf16x8 pa2, bf16x8 pa3) {
  if constexpr (MODE == 0) { pv_one<0>(o[0], vb, pa0, pa1, pa2, pa3); pv_one<1>(o[1], vb, pa0, pa1, pa2, pa3); pv_one<2>(o[2], vb, pa0, pa1, pa2, pa3); pv_one<3>(o[3], vb, pa0, pa1, pa2, pa3); }
  else { if (kvh == 0) { pv_one<0>(o[0], vb, pa0, pa1, pa2, pa3); pv_one<1>(o[1], vb, pa0, pa1, pa2, pa3); } else { pv_one<2>(o[0], vb, pa0, pa1, pa2, pa3); pv_one<3>(o[1], vb, pa0, pa1, pa2, pa3); } }
}
__device__ __forceinline__ void band_mask(f32x16& p0, f32x16& p1, int dj, int hi) {
#pragma unroll
  for (int r = 0; r < 16; ++r) { const int d = dj + (r & 3) + 8 * (r >> 2) + 4 * hi;
    if ((unsigned)(d + 128) > 256u) p0[r] = -1e30f;
    if ((unsigned)(d + 160) > 256u) p1[r] = -1e30f; }
}

template <int MODE, int LDK, int NO>
__device__ __forceinline__ void attn_core(const bf16_t* Qw, const bf16_t* __restrict__ Kh, const bf16_t* __restrict__ Vh, int NT, int base0, int n0, int base1, int mbase, int coff,
                                          float m0, float l0, int kvh, f32x16 (&o)[NO], float& l_out, char* lds, const int tid) {
  const int wid = tid >> 6, lane = tid & 63, r32 = lane & 31, hi = lane >> 5;
  char* V_lds = lds + OFF_V; char* K_lds = lds + OFF_K;
  float* ws = (float*)(lds + OFF_WS) + wid * 64; float* al_l = ws + 32;
  float m_reg = m0, l_reg = l0; bf16x8 qr[4];
#pragma unroll
  for (int d = 0; d < NO; ++d) o[d] = f32x16{};
#pragma unroll
  for (int d0 = 0; d0 < 4; ++d0) qr[d0] = *reinterpret_cast<const bf16x8*>(Qw + d0 * 16);
  const int sr = tid >> 4, sc = (tid & 15) * 8, vst0 = v_st(sr, sc), vst1 = v_st(32 + sr, sc);
  const int vb0 = (int)(uintptr_t)V_lds + v_rd_base(lane);
  struct { bf16x8 vs0, vs1, ks0, ks1; } sr_[2];
#define TROW(j) ((long)((j) < n0 ? base0 + 64 * (j) : base1 + 64 * ((j) - n0)))
#define SLOAD(i, j) do { const long _r = TROW(j); sr_[i].vs0 = *reinterpret_cast<const bf16x8*>(&Vh[(_r + sr) * LDK + sc]); sr_[i].vs1 = *reinterpret_cast<const bf16x8*>(&Vh[(_r + 32 + sr) * LDK + sc]); \
    sr_[i].ks0 = *reinterpret_cast<const bf16x8*>(&Kh[(_r + sr) * LDK + sc]); sr_[i].ks1 = *reinterpret_cast<const bf16x8*>(&Kh[(_r + 32 + sr) * LDK + sc]); } while (0)
#define SWRITE(b, i) do { *(bf16x8*)(V_lds + (b) * SHM_V + vst0) = sr_[i].vs0;          \
    *(bf16x8*)(V_lds + (b) * SHM_V + vst1) = sr_[i].vs1; int kc = sc * 2;               \
    *(bf16x8*)(K_lds + (b) * SHM_K + KSWZ(sr, kc)) = sr_[i].ks0;                       \
    *(bf16x8*)(K_lds + (b) * SHM_K + KSWZ(32 + sr, kc)) = sr_[i].ks1; } while (0)
#define SWAIT() asm volatile("s_waitcnt vmcnt(4)" ::: "memory")
#define RESC(a) do { if (__any((a) < 1.f)) { if (hi == 0) al_l[r32] = (a); asm volatile("s_waitcnt lgkmcnt(0)" ::: "memory"); \
    _Pragma("unroll") for (int d = 0; d < NO; ++d) _Pragma("unroll") for (int r = 0; r < 16; ++r) o[d][r] *= al_l[crow(r, hi)]; } } while (0)
#define MASKT(P0, P1, j) do { if constexpr (MODE == 1) { if ((j) >= 4) band_mask(P0, P1, mbase + 64 * ((j) - 4), hi); } } while (0)
  f32x16 pA0, pA1, pB0, pB1; float mnA, mnB, alA, alB; bf16x8 pa0, pa1, pa2, pa3;
  constexpr int SE = 0, SO = 1;
  SLOAD(SE, 0); asm volatile("s_waitcnt vmcnt(0)" ::: "memory"); SWRITE(0, SE); __syncthreads();
  qkt(pA0, pA1, K_lds, qr, r32, hi, coff); MASKT(pA0, pA1, 0); partialSM(pA0, pA1, m_reg, mnA, alA);
  SLOAD(SO, 1); if (2 < NT) SLOAD(SE, 2);
  SWAIT(); SWRITE(1, SO); __syncthreads();
  for (int j = 1; j + 1 < NT; j += 2) {
    SBAR(); qkt(pB0, pB1, K_lds + SHM_K, qr, r32, hi, coff); MASKT(pB0, pB1, j);
    finishSM(pA0, pA1, alA, l_reg, pa0, pa1, pa2, pa3); SBAR();
    SLOAD(SO, j + 2); SBAR();
    pv_all<MODE>(o, vb0, kvh, pa0, pa1, pa2, pa3); partialSM(pB0, pB1, m_reg, mnB, alB);
    __syncthreads(); SWAIT(); SWRITE(0, SE);
    RESC(alB); __syncthreads();
    SBAR(); qkt(pA0, pA1, K_lds, qr, r32, hi, coff); MASKT(pA0, pA1, j + 1);
    finishSM(pB0, pB1, alB, l_reg, pa0, pa1, pa2, pa3); SBAR();
    if (j + 3 < NT) SLOAD(SE, j + 3); SBAR();
    pv_all<MODE>(o, vb0 + SHM_V, kvh, pa0, pa1, pa2, pa3); partialSM(pA0, pA1, m_reg, mnA, alA);
    __syncthreads(); SWAIT(); SWRITE(1, SO);
    RESC(alA); __syncthreads();
  }
  SBAR(); qkt(pB0, pB1, K_lds + SHM_K, qr, r32, hi, coff); MASKT(pB0, pB1, NT - 1);
  finishSM(pA0, pA1, alA, l_reg, pa0, pa1, pa2, pa3); SBAR();
  pv_all<MODE>(o, vb0, kvh, pa0, pa1, pa2, pa3); partialSM(pB0, pB1, m_reg, mnB, alB);
  __syncthreads(); RESC(alB);
  finishSM(pB0, pB1, alB, l_reg, pa0, pa1, pa2, pa3); SBAR();
  pv_all<MODE>(o, vb0 + SHM_V, kvh, pa0, pa1, pa2, pa3);
  l_out = l_reg;
#undef TROW
#undef SLOAD
#undef SWRITE
#undef SWAIT
#undef RESC
#undef MASKT
}

__device__ __forceinline__ void diff_unit(const bf16_t* Qb, const bf16_t* Kb, const bf16_t* Vb, bf16_t* Aout, int b, int h, int qb, int isctx, float lam, const float* subln, char* lds, const int tid) {
  const int wid = __builtin_amdgcn_readfirstlane(tid >> 6), lane = tid & 63, r32 = lane & 31, hi = lane >> 5;
  const int map = wid >> 2, wq = wid & 3;
  const int cbase = ML + b * CTXL;
  const int qrow0 = isctx ? cbase + qb * 128 : b * SEQ + qb * 128;
  const int NT = isctx ? 4 : 36, base0 = isctx ? cbase : b * SEQ, n0 = isctx ? 4 : 32;
  const bf16_t* Qw = Qb + (size_t)(qrow0 + wq * 32 + r32) * 512 + h * 128 + map * 64 + hi * 8;
  f32x16 o[4]; float l_reg;
  attn_core<0, 512, 4>(Qw, Kb + h * 128, Vb + h * 128, NT, base0, n0, cbase, 0, map * 64, -1e30f, 0.f, 0, o, l_reg, lds, tid);
  float* ws = (float*)(lds + OFF_WS) + wid * 64;
  if (hi == 0) ws[r32] = l_reg;
  asm volatile("s_waitcnt lgkmcnt(0)" ::: "memory");
  float* stg = (float*)(lds + OFF_STG);
  const float sgn = map ? -lam : 1.f;
  float rli[16];
#pragma unroll
  for (int r = 0; r < 16; ++r) rli[r] = sgn * __builtin_amdgcn_rcpf(ws[crow(r, hi)]);
  if (map == 1) {
#pragma unroll
    for (int r = 0; r < 16; ++r)
#pragma unroll
      for (int d0 = 0; d0 < 4; ++d0) stg[(wq * 32 + crow(r, hi)) * STG_LD + d0 * 32 + r32] = o[d0][r] * rli[r];
  }
  __syncthreads();
  if (map == 0) {
#pragma unroll
    for (int r = 0; r < 16; ++r)
#pragma unroll
      for (int d0 = 0; d0 < 4; ++d0) stg[(wq * 32 + crow(r, hi)) * STG_LD + d0 * 32 + r32] += o[d0][r] * rli[r];
  }
  __syncthreads();
  { const int row = tid >> 2, part = tid & 3; const float* sp = stg + row * STG_LD + part * 32; f32x4 v[8]; float ss = 0.f;
#pragma unroll
    for (int i = 0; i < 8; ++i) { v[i] = *(const f32x4*)(sp + 4 * i); ss += (v[i][0] * v[i][0] + v[i][1] * v[i][1]) + (v[i][2] * v[i][2] + v[i][3] * v[i][3]); }
    ss += __shfl_xor(ss, 1); ss += __shfl_xor(ss, 2);
    const float rn = 0.8f / sqrtf(ss * (1.f / 128.f) + EPS);
    bf16_t* op = Aout + (size_t)(qrow0 + row) * DM + 512 + h * 128 + part * 32;
#pragma unroll
    for (int i = 0; i < 4; ++i) { const f32x4 w0 = *(const f32x4*)(subln + part * 32 + 8 * i), w1 = *(const f32x4*)(subln + part * 32 + 8 * i + 4);
      *(u32x4*)(op + 8 * i) = pack8(v[2 * i] * w0 * rn, v[2 * i + 1] * w1 * rn); }
  }
  __syncthreads();
}

__device__ __forceinline__ void win_unit(const bf16_t* Q2, const bf16_t* K2, const bf16_t* V2, bf16_t* Aout, int b, int qb, int g, const float* sink, char* lds, const int tid) {
  const int wid = __builtin_amdgcn_readfirstlane(tid >> 6), lane = tid & 63, r32 = lane & 31, hi = lane >> 5;
  const int kvh = wid >> 2, wq = wid & 3, head = kvh * 4 + g;
  const int q0 = qb * 128, lo = q0 >= 128 ? q0 - 128 : 0, hk = (q0 + 256 <= SEQ) ? q0 + 256 : SEQ, NT = 4 + (hk - lo) / 64;
  const int qrow0 = b * SEQ + q0, cbase = ML + b * CTXL;
  const bf16_t* Qw = Q2 + (size_t)(qrow0 + wq * 32 + r32) * 512 + head * 64 + hi * 8;
  const int mbase = lo - q0 - wq * 32 - r32;
  f32x16 o[2]; float l_reg;
  attn_core<1, 128, 2>(Qw, K2, V2, NT, cbase, 4, b * SEQ + lo, mbase, kvh * 64, sink[head] * 8.0f, 1.0f, kvh, o, l_reg, lds, tid);
  float* ws = (float*)(lds + OFF_WS) + wid * 64;
  if (hi == 0) ws[r32] = l_reg;
  asm volatile("s_waitcnt lgkmcnt(0)" ::: "memory");
  float rli[16];
#pragma unroll
  for (int r = 0; r < 16; ++r) rli[r] = __builtin_amdgcn_rcpf(ws[crow(r, hi)]);
  bf16_t* op = Aout + (size_t)(qrow0 + wq * 32) * DM + head * 64 + r32;
#pragma unroll
  for (int r = 0; r < 16; ++r)
#pragma unroll
    for (int dl = 0; dl < 2; ++dl) op[(size_t)crow(r, hi) * DM + dl * 32] = (bf16_t)f2bf(o[dl][r] * rli[r]);
  __syncthreads();
}
#undef KSWZ
#undef SBAR
}

#define XB_TMO      128
#define XB_XCNT(j)  (256  + 64 * (j))
#define XB_XSUB(j)  (1280 + 64 * (j))
#define XB_XGEN(j)  (2304 + 64 * (j))
#define XB_TOP      3328
#define XB_TOPGEN   3392
#define XCD_BAR_WORDS 3456
#define XB_SPIN_CAP (1u << 18)
__device__ __forceinline__ unsigned xb_ld(unsigned* p)              { return __hip_atomic_load(p, __ATOMIC_RELAXED, __HIP_MEMORY_SCOPE_AGENT); }
__device__ __forceinline__ unsigned xb_add(unsigned* p, unsigned v) { return __hip_atomic_fetch_add(p, v, __ATOMIC_RELAXED, __HIP_MEMORY_SCOPE_AGENT); }
__device__ __forceinline__ unsigned xb_xcc_id() { return (unsigned)__builtin_amdgcn_s_getreg((3 << 11) | 20) & 0xFu; }
#define XB_SPIN(cond, bar) do { unsigned _sp = 0; while (cond) { __builtin_amdgcn_s_sleep(1); \
    if ((++_sp & 255u) == 0u) { if (xb_ld(&(bar)[XB_TMO])) break; if (_sp > XB_SPIN_CAP) { atomicAdd(&(bar)[XB_TMO], 1u); break; } } } } while (0)
struct XcdBarrier { unsigned* bar; unsigned x; volatile LAS unsigned* st; };
__device__ __forceinline__ XcdBarrier xcd_barrier_post(unsigned* bar, volatile LAS unsigned* st) {
    XcdBarrier b; b.bar = bar; b.x = xb_xcc_id(); b.st = st;
    if (threadIdx.x == 0) (void)xb_add(&bar[XB_XCNT(b.x)], 1u);
    return b;
}
__device__ __forceinline__ void xcd_barrier_complete(unsigned* bar, unsigned x, unsigned& nloc, unsigned& nx) {
    const unsigned G = gridDim.x * gridDim.y * gridDim.z;
    unsigned sum, cnt, mine, sp = 0u;
    for (;;) {
        sum = 0u; cnt = 0u; mine = 0u;
#pragma unroll
        for (unsigned j = 0; j < 16; ++j) { const unsigned c = xb_ld(&bar[XB_XCNT(j)]); sum += c; cnt += (c > 0u) ? 1u : 0u; mine = (j == x) ? c : mine; }
        if (sum == G) break;
        __builtin_amdgcn_s_sleep(1);
        if ((++sp & 255u) == 0u) { if (xb_ld(&bar[XB_TMO])) break; if (sp > XB_SPIN_CAP) { atomicAdd(&bar[XB_TMO], 1u); break; } }
    }
    nloc = mine > 0u ? mine : 1u; nx = cnt > 0u ? cnt : 1u;
}
__device__ __forceinline__ void xcd_barrier(const XcdBarrier& b) {
    asm volatile("s_waitcnt vmcnt(0)" ::: "memory");
    __syncthreads();
    if (threadIdx.x == 0) {
        unsigned* bar = b.bar;
        __builtin_amdgcn_s_waitcnt(0);
        unsigned nloc = b.st[0], nx = b.st[1];
        if (nloc == 0u) { xcd_barrier_complete(bar, b.x, nloc, nx); b.st[0] = nloc; b.st[1] = nx; }
        const unsigned old = xb_add(&bar[XB_XSUB(b.x)], 1u);
        const unsigned gen = old / nloc;
        if (old + 1u == (gen + 1u) * nloc) {
            __builtin_amdgcn_fence(__ATOMIC_RELEASE, "agent");
            asm volatile("s_waitcnt vmcnt(0)" ::: "memory");
            const unsigned og = xb_add(&bar[XB_TOP], 1u);
            const unsigned tg = og / nx;
            if (og + 1u == (tg + 1u) * nx) xb_add(&bar[XB_TOPGEN], 1u);
            else XB_SPIN(xb_ld(&bar[XB_TOPGEN]) == tg, bar);
            __builtin_amdgcn_fence(__ATOMIC_ACQUIRE, "agent");
            xb_add(&bar[XB_XGEN(b.x)], 1u);
            asm volatile("s_waitcnt vmcnt(0)" ::: "memory");
        } else {
            XB_SPIN(xb_ld(&bar[XB_XGEN(b.x)]) == gen, bar);
            __builtin_amdgcn_fence(__ATOMIC_ACQUIRE, "agent");
            asm volatile("s_waitcnt vmcnt(0)" ::: "memory");
        }
    }
    __syncthreads();
}

constexpr int RING_BYTES = 131072, LDS_BYTES = 147456, LDSCTL_OFF = LDS_BYTES - 512, MISC_OFF = LDSCTL_OFF + 320;
#define LDS_WAIT() asm volatile("s_waitcnt lgkmcnt(0)" ::: "memory")

struct Args { const float* in[21]; float* out; unsigned char* ws; int lo, hi; };

enum { ST_PREPA = 0, ST_PREPB, ST_INAB, ST_ATT0, ST_OUTAB, ST_UP0, ST_FIX0, ST_DOWN0, ST_INCD, ST_ATT1, ST_OUTCD, ST_UP1, ST_FIX1, ST_DOWN1, ST_FINAL, N_STEPS };

template <int MAP> __device__ __forceinline__ int cmap(int n) { if constexpr (MAP == 1) return colmap_ab(n); else if constexpr (MAP == 2) return colmap_cd(n); else if constexpr (MAP == 3) return colmap_up(n); else return n; }
template <int MAP>
__device__ __forceinline__ void transpose_item(const float* W, int K, int N, bf16_t* WT, LAS float* scr, int item, int lane) {
    const int nblk = N / 32, kb = item / nblk, nb = item % nblk, k0 = 64 * kb, n0 = 32 * nb;
    const int srcc = cmap<MAP>(n0 + (lane & 31));
#pragma unroll 8
    for (int i = 0; i < 32; ++i) { const int kk = 2 * i + (lane >> 5); scr[kk * 33 + (lane & 31)] = W[(size_t)(k0 + kk) * N + srcc]; }
    LDS_WAIT(); asm volatile("" ::: "memory");
    const int c = lane & 7;
#pragma unroll
    for (int j = 0; j < 4; ++j) { const int n = (lane >> 3) + 8 * j; const LAS float* s = scr + (8 * c) * 33 + n;
        u32x4 o; o.x = cvt_pk_bf16(s[0 * 33], s[1 * 33]); o.y = cvt_pk_bf16(s[2 * 33], s[3 * 33]); o.z = cvt_pk_bf16(s[4 * 33], s[5 * 33]); o.w = cvt_pk_bf16(s[6 * 33], s[7 * 33]);
        *(u32x4*)(WT + (size_t)(n0 + n) * K + k0 + 8 * c) = o; }
    LDS_WAIT(); asm volatile("" ::: "memory");
}

enum { K_PREPA = 0, K_PREPB, K_INAB, K_ATT0, K_RES, K_UP, K_GATE, K_INCD, K_ATT1, K_FINAL, N_KINDS };
__host__ __device__ __forceinline__ int step_kind(int step) {
    if (step == ST_PREPA) return K_PREPA; if (step == ST_PREPB) return K_PREPB; if (step == ST_INAB) return K_INAB; if (step == ST_ATT0) return K_ATT0;
    if (step == ST_OUTAB || step == ST_DOWN0 || step == ST_OUTCD || step == ST_DOWN1) return K_RES;
    if (step == ST_INCD) return K_INCD; if (step == ST_ATT1) return K_ATT1; if (step == ST_FINAL) return K_FINAL;
    return (step == ST_UP0 || step == ST_UP1) ? K_UP : K_GATE;
}
#ifndef PHASE_MASK
#define PHASE_MASK 0x3ff
#endif
#define HAS(k) ((KIND < 0 && ((PHASE_MASK >> (k)) & 1)) || KIND == (k))
template <int KIND>
__global__ void __launch_bounds__(NWAVES * 64, 2) fwd_kernel(Args args) {
    extern __shared__ __attribute__((aligned(16))) unsigned char lds[];
    LAS unsigned char* ldsl = (LAS unsigned char*)lds;
    volatile LAS unsigned* MISC = (volatile LAS unsigned*)(ldsl + MISC_OFF);
    const int tid0 = threadIdx.x;
    const int G = gridDim.x, bx = blockIdx.x;
    for (int u = tid0; u < (LDS_BYTES - LDSCTL_OFF) / 4; u += NWAVES * 64) ((LAS unsigned*)(ldsl + LDSCTL_OFF))[u] = 0u;
    __syncthreads();
    XcdBarrier bar; bar.bar = (unsigned*)(args.ws + WS_CTL) + CW_BAR; bar.x = 0; bar.st = nullptr;
    if (ONE_LAUNCH) bar = xcd_barrier_post((unsigned*)(args.ws + WS_CTL) + CW_BAR, MISC + 8);

    for (int step = args.lo; step < args.hi; ++step) {
        const int kind = step_kind(step);
        int bxs = bx; asm volatile("" : "+s"(bxs));
        int tid = tid0; asm volatile("" : "+v"(tid));
        size_t wso = 0; asm volatile("" : "+s"(wso)); unsigned char* ws = args.ws + wso;
        const int lane = tid & 63, wave = __builtin_amdgcn_readfirstlane(tid >> 6);
        const int vcu = (G % 8 == 0) ? (bxs % 8) * (G / 8) + bxs / 8 : bxs;
        const int gw = vcu * NWAVES + wave, NGW = G * NWAVES;
        const float* x = args.in[0]; const float* cvec = args.in[1]; const float* ctx = args.in[2]; const float* cctx = args.in[3];
        const float* w_mod = args.in[4]; const float* b_mod = args.in[5]; const float* w_in_ab = args.in[6]; const float* conv_a = args.in[7];
        const float* lam_qk = args.in[8]; const float* subln = args.in[9]; const float* w_out_ab = args.in[10]; const float* w_in_cd = args.in[11];
        const float* sink_c = args.in[12]; const float* pool_w = args.in[13]; const float* pool_scale = args.in[14]; const float* w_out_cd = args.in[15];
        const float* w_up = args.in[16]; const float* conv_w = args.in[17]; const float* conv_b = args.in[18]; const float* w_down = args.in[19];
        const float* fnw = args.in[20];
        float* out = args.out;
        float* mods = (float*)(ws + WS_MODS); float* bup0 = (float*)(ws + WS_BUP0); float* bup1 = (float*)(ws + WS_BUP1); float* bcd = (float*)(ws + WS_BCD);
        float* ropec = (float*)(ws + WS_ROPEC); float* ropes = (float*)(ws + WS_ROPES); float* lamp = (float*)(ws + WS_LAM);
        bf16_t* Wab = (bf16_t*)(ws + WS_WAB); bf16_t* Woab = (bf16_t*)(ws + WS_WOAB); bf16_t* Wcd = (bf16_t*)(ws + WS_WCD); bf16_t* Wocd = (bf16_t*)(ws + WS_WOCD);
        bf16_t* Wup0 = (bf16_t*)(ws + WS_WUP0); bf16_t* Wup1 = (bf16_t*)(ws + WS_WUP1); bf16_t* Wdn0 = (bf16_t*)(ws + WS_WDN0); bf16_t* Wdn1 = (bf16_t*)(ws + WS_WDN1);
        float* XC = (float*)(ws + WS_XC); float* ssqA = (float*)(ws + WS_SSQA); float* ssqB = (float*)(ws + WS_SSQB);
        bf16_t* A1 = (bf16_t*)(ws + WS_A1); bf16_t* A2 = (bf16_t*)(ws + WS_A2);
        bf16_t* GB = (bf16_t*)(ws + WS_GB); bf16_t* Pb = (bf16_t*)(ws + WS_P); bf16_t* Qb = (bf16_t*)(ws + WS_Q); bf16_t* Kb = (bf16_t*)(ws + WS_K); bf16_t* Vb = (bf16_t*)(ws + WS_V);
        bf16_t* ACT = (bf16_t*)(ws + WS_ACT); bf16_t* Q2 = (bf16_t*)(ws + WS_Q2); bf16_t* PL = (bf16_t*)(ws + WS_PL); bf16_t* K2 = (bf16_t*)(ws + WS_K2); bf16_t* V2 = (bf16_t*)(ws + WS_V2);
        float* EDGEb = (float*)(ws + WS_U);
        if (HAS(K_PREPA) && kind == K_PREPA) {
            if (bxs < 192) {
                const int l = bxs / 96, nc = bxs % 96;
                LAS float* st = (LAS float*)ldsl;
                for (int e = tid; e < 17 * 1024; e += NWAVES * 64) { const int v = e >> 10, k = e & 1023; const float xv = v < 16 ? cvec[v * 1024 + k] : cctx[k]; st[k * 20 + v] = xv / (1.0f + expf(-xv)); }
                __syncthreads();
                float acc[17];
#pragma unroll
                for (int v = 0; v < 17; ++v) acc[v] = 0.f;
                const float* wp = w_mod + (size_t)l * 1024 * 6144 + nc * 64 + lane;
                for (int k0 = wave * 128; k0 < wave * 128 + 128; k0 += 8) {
                    float wv[8];
#pragma unroll
                    for (int uu = 0; uu < 8; ++uu) wv[uu] = wp[(size_t)(k0 + uu) * 6144];
#pragma unroll
                    for (int uu = 0; uu < 8; ++uu) { const LAS f32x4* sp = (const LAS f32x4*)(st + (k0 + uu) * 20);
                        const f32x4 s0 = sp[0], s1 = sp[1], s2 = sp[2], s3 = sp[3]; const float s16 = st[(k0 + uu) * 20 + 16];
#pragma unroll
                        for (int j = 0; j < 4; ++j) { acc[j] += s0[j] * wv[uu]; acc[4 + j] += s1[j] * wv[uu]; acc[8 + j] += s2[j] * wv[uu]; acc[12 + j] += s3[j] * wv[uu]; }
                        acc[16] += s16 * wv[uu]; }
                }
                LAS float* red = (LAS float*)(ldsl + 81920);
#pragma unroll
                for (int v = 0; v < 17; ++v) red[(wave * 17 + v) * 64 + lane] = acc[v];
                __syncthreads();
                for (int e = tid; e < 17 * 64; e += NWAVES * 64) { const int v = e >> 6, ln = e & 63; float s = 0.f;
#pragma unroll
                    for (int w = 0; w < 8; ++w) s += red[(w * 17 + v) * 64 + ln];
                    const int n = nc * 64 + ln; mods[(size_t)(l * 17 + v) * 6144 + n] = s + b_mod[l * 6144 + n]; }
                __syncthreads();
            } else if (bxs == 192) {
                for (int e = tid; e < 1024; e += NWAVES * 64) { const int pos = e >> 4, i = e & 15;
                    const float inv = __builtin_amdgcn_exp2f(-(float)i * (13.287712379549449f / 16.0f)); const float ang = (float)pos * inv;
                    double xr = (double)ang; const double n2 = rint(xr * 0.15915494309189535); xr -= n2 * 6.283185307179586;
                    double sn = xr, cs = 1.0, ts = xr, tc = 1.0; const double x2 = xr * xr;
                    for (int q = 1; q < 16; ++q) { tc *= -x2 / (double)((2 * q - 1) * (2 * q)); ts *= -x2 / (double)((2 * q) * (2 * q + 1)); cs += tc; sn += ts; }
                    ropec[e] = (float)cs; ropes[e] = (float)sn; }
            } else if (bxs == 193) {
                if (tid == 0) { float d1 = 0.f, d2 = 0.f; for (int i = 0; i < 64; ++i) { d1 += lam_qk[i] * lam_qk[64 + i]; d2 += lam_qk[128 + i] * lam_qk[192 + i]; }
                    lamp[0] = expf(d1) - expf(d2) + 0.2f; }
            }
            {
                LAS float* scr = (LAS float*)(ldsl + wave * 16384);
                constexpr int I_AB = 16 * 96, I_OAB = 16 * 32, I_CD = 16 * 40, I_OCD = 8 * 32, I_UP = 16 * 176, I_DN = 44 * 32;
                constexpr int NITEMS = I_AB + I_OAB + I_CD + I_OCD + 2 * I_UP + 2 * I_DN;
                for (int it = gw; it < NITEMS; it += NGW) {
                    int r = it;
                    if (r < I_AB) { transpose_item<1>(w_in_ab, 1024, NAB, Wab, scr, r, lane); continue; } r -= I_AB;
                    if (r < I_OAB) { transpose_item<0>(w_out_ab, 1024, 1024, Woab, scr, r, lane); continue; } r -= I_OAB;
                    if (r < I_CD) { transpose_item<2>(w_in_cd, 1024, NCD, Wcd, scr, r, lane); continue; } r -= I_CD;
                    if (r < I_OCD) { transpose_item<0>(w_out_cd, 1024, 1024, Wocd, scr, r, lane); continue; } r -= I_OCD;
                    if (r < I_UP) { transpose_item<3>(w_up, 1024, NUP, Wup0, scr, r, lane); continue; } r -= I_UP;
                    if (r < I_UP) { transpose_item<3>(w_up + (size_t)1024 * NUP, 1024, NUP, Wup1, scr, r, lane); continue; } r -= I_UP;
                    if (r < I_DN) { transpose_item<0>(w_down, DFF, 1024, Wdn0, scr, r, lane); continue; } r -= I_DN;
                    transpose_item<0>(w_down + (size_t)DFF * 1024, DFF, 1024, Wdn1, scr, r, lane);
                }
                for (int it = gw; it < 512 * 16; it += NGW) { const int kp = it >> 4, nch = it & 15, gq = kp >> 7, n = nch * 64 + lane; float s = 0.f;
                    const float* pw = pool_w + (size_t)kp * 128; const float* psc = pool_scale + gq * 128; const float* wo = w_out_cd + (size_t)(512 + gq * 128) * 1024 + n;
#pragma unroll 8
                    for (int e = 0; e < 128; ++e) s += pw[e] * psc[e] * wo[(size_t)e * 1024];
                    Wocd[(size_t)n * 1024 + 512 + kp] = (bf16_t)f2bf(s); }
            }
        }
        else if (HAS(K_PREPB) && kind == K_PREPB) {
            for (int m = gw; m < MT; m += NGW) {
                const float* xr = m < ML ? x + (size_t)m * DM : ctx + (size_t)(m - ML) * DM; const int bvec = m < ML ? (m >> 11) : 16;
                const f32x4* xp = (const f32x4*)xr + lane; f32x4 v[4]; float ss = 0.f;
#pragma unroll
                for (int j = 0; j < 4; ++j) { v[j] = xp[64 * j]; ss += (v[j][0] * v[j][0] + v[j][1] * v[j][1]) + (v[j][2] * v[j][2] + v[j][3] * v[j][3]); }
                const float rs = 1.0f / sqrtf(wave_sum(ss) * (1.0f / DM) + EPS);
                const f32x4* shp = (const f32x4*)(mods + (size_t)bvec * 6144) + lane; const f32x4* scp = (const f32x4*)(mods + (size_t)bvec * 6144 + 1024) + lane;
                u32x2* op = (u32x2*)(A1 + (size_t)m * DM) + lane;
#pragma unroll
                for (int j = 0; j < 4; ++j) { const f32x4 h = v[j] * rs * (scp[64 * j] + 1.0f) + shp[64 * j]; u32x2 w; w.x = cvt_pk_bf16(h[0], h[1]); w.y = cvt_pk_bf16(h[2], h[3]); op[64 * j] = w; }
            }
            for (int it = gw; it < 2 * NUP + NCD; it += NGW) {
                const bf16_t* wt; const float* sh; float* bo; int n, N;
                if (it < NUP) { n = it; N = NUP; wt = Wup0; sh = mods + 3 * 1024; bo = bup0; }
                else if (it < 2 * NUP) { n = it - NUP; N = NUP; wt = Wup1; sh = mods + (size_t)17 * 6144 + 3 * 1024; bo = bup1; }
                else { n = it - 2 * NUP; N = NCD; wt = Wcd; sh = mods + (size_t)17 * 6144; bo = bcd; }
                const u32x4* wp = (const u32x4*)(wt + (size_t)n * 1024 + lane * 16); float wf[16]; { float t8[8]; unpack8(wp[0], t8);
#pragma unroll
                    for (int j = 0; j < 8; ++j) wf[j] = t8[j]; unpack8(wp[1], t8);
#pragma unroll
                    for (int j = 0; j < 8; ++j) wf[8 + j] = t8[j]; }
                for (int v = 0; v < 17; ++v) { const f32x4* sp = (const f32x4*)(sh + (size_t)v * 6144 + lane * 16); float p = 0.f;
#pragma unroll
                    for (int j = 0; j < 4; ++j) { const f32x4 s = sp[j]; p += (s[0] * wf[4 * j] + s[1] * wf[4 * j + 1]) + (s[2] * wf[4 * j + 2] + s[3] * wf[4 * j + 3]); }
                    p = wave_sum(p); if (lane == 0) bo[(size_t)v * N + n] = p; }
            }
        }
        else if (HAS(K_INAB) && kind == K_INAB) {
            pg8::Gemm g{A1, Wab, MT, NAB, 1024}; pg8::StaticOrder S; S.init(MT, NAB, G, bxs);
            pg8::EpiAB E{GB, Pb, Qb, Kb, Vb, ropec, ropes};
            pg8::gemm_phase<pg8::EpiAB, pg8::StaticOrder, true, true>(ldsl, g, S, E, tid);
        }
        else if (HAS(K_ATT0) && kind == K_ATT0) {
            const float lam = lamp[0];
            for (int ui = vcu; ui < 1024 + 128; ui += G) {
                if (ui < 1024) { const int bh = ui >> 4, qb = ui & 15; att::diff_unit(Qb, Kb, Vb, A2, bh >> 2, bh & 3, qb, 0, lam, subln, (char*)lds, tid); }
                else { const int uc = ui - 1024, bh = uc >> 1, qb = uc & 1; att::diff_unit(Qb, Kb, Vb, A2, bh >> 2, bh & 3, qb, 1, lam, subln, (char*)lds, tid); }
            }
            for (int it = vcu; it < MT / 64; it += G) {
                for (int e = tid; e < 64 * 64; e += NWAVES * 64) { const int r = it * 64 + (e >> 6), c = (e & 63) * 8;
                    const int L = r < ML ? SEQ : CTXL, pos = r < ML ? (r & (SEQ - 1)) : ((r - ML) & (CTXL - 1));
                    float pc[8], pm[8], pp[8], gbv[8];
                    unpack8(*(const u32x4*)(Pb + (size_t)r * 512 + c), pc); unpack8(*(const u32x4*)(GB + (size_t)r * 512 + c), gbv);
                    if (pos > 0) unpack8(*(const u32x4*)(Pb + (size_t)(r - 1) * 512 + c), pm); else {
#pragma unroll
                        for (int j = 0; j < 8; ++j) pm[j] = 0.f; }
                    if (pos < L - 1) unpack8(*(const u32x4*)(Pb + (size_t)(r + 1) * 512 + c), pp); else {
#pragma unroll
                        for (int j = 0; j < 8; ++j) pp[j] = 0.f; }
                    const f32x4 w0a = *(const f32x4*)(conv_a + c), w0b = *(const f32x4*)(conv_a + c + 4), w1a = *(const f32x4*)(conv_a + 512 + c), w1b = *(const f32x4*)(conv_a + 512 + c + 4),
                                w2a = *(const f32x4*)(conv_a + 1024 + c), w2b = *(const f32x4*)(conv_a + 1024 + c + 4);
                    f32x4 oa, ob;
#pragma unroll
                    for (int j = 0; j < 4; ++j) { oa[j] = gbv[j] * (w0a[j] * pm[j] + w1a[j] * pc[j] + w2a[j] * pp[j]); ob[j] = gbv[4 + j] * (w0b[j] * pm[4 + j] + w1b[j] * pc[4 + j] + w2b[j] * pp[4 + j]); }
                    *(u32x4*)(A2 + (size_t)r * DM + c) = pack8(oa, ob); }
            }
        }
        else if (HAS(K_RES) && kind == K_RES) {
            const int which = (step == ST_OUTAB) ? 0 : (step == ST_DOWN0) ? 1 : (step == ST_OUTCD) ? 2 : 3;
            const bool isdown = (which & 1) != 0; const int layer = which >> 1, M = layer ? ML : MT;
            float* const mods_l = mods + (size_t)layer * 17 * 6144;
            pg8::Gemm g; g.A = isdown ? ACT : (layer ? A1 : A2); g.Bt = isdown ? (layer ? Wdn1 : Wdn0) : (layer ? Wocd : Woab); g.M = M; g.N = 1024; g.K = isdown ? DFF : 1024;
            pg8::EpiRes E;
            E.xin_lat = which == 0 ? x : (const float*)out; E.xin_ctx = which == 0 ? ctx : (const float*)XC; E.xout_lat = out; E.xout_ctx = XC;
            E.Aout = which == 0 ? A1 : A2; E.has_a = which != 3;
            E.gate = mods_l + (isdown ? 5 : 2) * 1024;
            E.scl = which == 1 ? mods + (size_t)17 * 6144 + 1024 : mods_l + 4 * 1024;
            E.ssq = isdown ? ssqB : ssqA;
            pg8::StaticOrder S; S.init(M, 1024, G, bxs);
            pg8::gemm_phase<pg8::EpiRes, pg8::StaticOrder, true, true>(ldsl, g, S, E, tid);
        }
        else if ((HAS(K_UP) || HAS(K_GATE)) && (kind == K_UP || kind == K_GATE)) {
            const int layer = (step == ST_UP1 || step == ST_FIX1) ? 1 : 0, M = layer ? ML : MT;
            const float* cw = conv_w + (size_t)layer * 3 * NUP; const float* cb = conv_b + (size_t)layer * NUP;
            if (HAS(K_UP) && kind == K_UP) {
                pg8::Gemm g{layer ? A2 : A1, layer ? Wup1 : Wup0, M, NUP, 1024}; pg8::StaticOrder S; S.init(M, NUP, G, bxs);
                pg8::EpiUpF E{ACT, ssqA, layer ? bup1 : bup0, cw, cb, EDGEb, (LAS float*)(ldsl + RING_BYTES), (bf16_t*)(ws + WS_JUNK)};
                pg8::gemm_phase<pg8::EpiUpF, pg8::StaticOrder, true, true>(ldsl, g, S, E, tid);
            } else if (HAS(K_GATE) && kind == K_GATE) {
                const int total = (M / 256) * 2 * 352;
                for (int e = bxs * (NWAVES * 64) + tid; e < total; e += G * NWAVES * 64) {
                    const int g8 = e % 352, wh = (e / 352) & 1, pm = e / 704, ch = g8 * 8, gcol = 256 * (ch >> 7) + (ch & 127);
                    const int r = pm * 256 + (wh ? 255 : 0), L = r < ML ? SEQ : CTXL, pos = r < ML ? (r & (SEQ - 1)) : ((r - ML) & (CTXL - 1));
                    const float* ec = EDGEb + (size_t)(pm * 4 + (wh ? 3 : 0)) * NUP + gcol;
                    const float* em = wh ? EDGEb + (size_t)(pm * 4 + 2) * NUP + gcol : EDGEb + (size_t)((pm - 1) * 4 + 3) * NUP + gcol;
                    const float* ep = wh ? EDGEb + (size_t)((pm + 1) * 4 + 0) * NUP + gcol : EDGEb + (size_t)(pm * 4 + 1) * NUP + gcol;
                    const bool hm = wh ? true : (pos > 0), hp = wh ? (pos < L - 1) : true;
                    const f32x4 z4 = (f32x4){0.f, 0.f, 0.f, 0.f};
                    f32x4 o[2];
#pragma unroll
                    for (int q = 0; q < 2; ++q) {
                        const f32x4 ac = *(const f32x4*)(ec + 4 * q), gc = *(const f32x4*)(ec + 128 + 4 * q);
                        const f32x4 am = hm ? *(const f32x4*)(em + 4 * q) : z4, gm = hm ? *(const f32x4*)(em + 128 + 4 * q) : z4;
                        const f32x4 ap = hp ? *(const f32x4*)(ep + 4 * q) : z4, gp = hp ? *(const f32x4*)(ep + 128 + 4 * q) : z4;
                        const int ca = ch + 4 * q, cg = DFF + ch + 4 * q;
                        const f32x4 av = *(const f32x4*)(cw + ca) * am + *(const f32x4*)(cw + NUP + ca) * ac + *(const f32x4*)(cw + 2 * NUP + ca) * ap + *(const f32x4*)(cb + ca);
                        const f32x4 gv = *(const f32x4*)(cw + cg) * gm + *(const f32x4*)(cw + NUP + cg) * gc + *(const f32x4*)(cw + 2 * NUP + cg) * gp + *(const f32x4*)(cb + cg);
#pragma unroll
                        for (int j = 0; j < 4; ++j) o[q][j] = av[j] * gv[j] * __builtin_amdgcn_rcpf(1.0f + __builtin_amdgcn_exp2f(-1.4426950408889634f * gv[j]));
                    }
                    *(u32x4*)(ACT + (size_t)r * DFF + ch) = pack8(o[0], o[1]);
                }
            }
        }
        else if (HAS(K_INCD) && kind == K_INCD) {
            pg8::Gemm g{A2, Wcd, MT, NCD, 1024}; pg8::StaticOrder S; S.init(MT, NCD, G, bxs);
            pg8::EpiCD E{Q2, K2, V2, PL, ssqB, bcd, ropec, ropes};
            pg8::gemm_phase<pg8::EpiCD, pg8::StaticOrder, true, true>(ldsl, g, S, E, tid);
        }
        else if (HAS(K_ATT1) && kind == K_ATT1) {
            for (int ui = vcu; ui < 1024; ui += G) { const int b = ui >> 6, qb = (ui >> 2) & 15, gq = ui & 3; att::win_unit(Q2, K2, V2, A1, b, qb, gq, sink_c, (char*)lds, tid); }
            for (int it = vcu; it < ML / 64; it += G) {
                for (int e = tid; e < 64 * 64; e += NWAVES * 64) { const int r = it * 64 + (e >> 6), c = (e & 63) * 8, gq = c >> 7, hw = 1 << gq;
                    const int pos = r & (SEQ - 1), rbase = r - pos; const int lo = pos - hw > 0 ? pos - hw : 0, hi = pos + hw < SEQ ? pos + hw : SEQ;
                    float s[8], t8[8];
#pragma unroll
                    for (int j = 0; j < 8; ++j) s[j] = 0.f;
                    for (int q = lo; q < hi; ++q) { unpack8(*(const u32x4*)(PL + (size_t)(rbase + q) * 512 + c), t8);
#pragma unroll
                        for (int j = 0; j < 8; ++j) s[j] += t8[j]; }
                    unpack8(*(const u32x4*)(PL + (size_t)r * 512 + c), t8); const float inv = 1.0f / (float)(hi - lo);
                    *(u32x4*)(A1 + (size_t)r * DM + 512 + c) = pack8((f32x4){s[0] * inv - t8[0], s[1] * inv - t8[1], s[2] * inv - t8[2], s[3] * inv - t8[3]},
                                                                      (f32x4){s[4] * inv - t8[4], s[5] * inv - t8[5], s[6] * inv - t8[6], s[7] * inv - t8[7]}); }
            }
        }
        else if (HAS(K_FINAL) && kind == K_FINAL) {
            for (int m = gw; m < ML; m += NGW) {
                const float rs = pg8::row_rs(ssqB, m);
                f32x4* xp = (f32x4*)(out + (size_t)m * DM) + lane; const f32x4* wp = (const f32x4*)fnw + lane;
#pragma unroll
                for (int j = 0; j < 4; ++j) xp[64 * j] = xp[64 * j] * rs * wp[64 * j];
            }
        }
        if (step + 1 < args.hi) { if (ONE_LAUNCH) xcd_barrier(bar); }
    }
}

extern "C" void kernel_launch(void* const* d_in, const int* in_sizes, int n_in, void* d_out, int out_size, void* d_ws, size_t ws_size, hipStream_t stream) {
    static int grid = 0;
    if (grid == 0) {
        if (n_in != 21 || in_sizes[0] != ML * DM || out_size != ML * DM || ws_size < WS_END) { fprintf(stderr, "kernel_launch: unexpected shapes (n_in %d, in0 %d, out %d, ws %zu < %zu)\n", n_in, n_in > 0 ? in_sizes[0] : -1, out_size, ws_size, (size_t)WS_END); grid = -1; return; }
        int dev = 0, cus = 0, per_cu = 0;
        if (hipGetDevice(&dev) != hipSuccess || hipDeviceGetAttribute(&cus, hipDeviceAttributeMultiprocessorCount, dev) != hipSuccess) { fprintf(stderr, "kernel_launch: device query failed\n"); grid = -1; return; }
        bool okattr = true;
#if ONE_LAUNCH
        okattr = hipFuncSetAttribute((const void*)fwd_kernel<-1>, hipFuncAttributeMaxDynamicSharedMemorySize, LDS_BYTES) == hipSuccess;
        if (hipOccupancyMaxActiveBlocksPerMultiprocessor(&per_cu, (const void*)fwd_kernel<-1>, NWAVES * 64, LDS_BYTES) != hipSuccess || per_cu < 1) fprintf(stderr, "kernel_launch: occupancy query reports %d\n", per_cu);
#else
        okattr = okattr && hipFuncSetAttribute((const void*)fwd_kernel<0>, hipFuncAttributeMaxDynamicSharedMemorySize, LDS_BYTES) == hipSuccess;
        okattr = okattr && hipFuncSetAttribute((const void*)fwd_kernel<1>, hipFuncAttributeMaxDynamicSharedMemorySize, LDS_BYTES) == hipSuccess;
        okattr = okattr && hipFuncSetAttribute((const void*)fwd_kernel<2>, hipFuncAttributeMaxDynamicSharedMemorySize, LDS_BYTES) == hipSuccess;
        okattr = okattr && hipFuncSetAttribute((const void*)fwd_kernel<3>, hipFuncAttributeMaxDynamicSharedMemorySize, LDS_BYTES) == hipSuccess;
        okattr = okattr && hipFuncSetAttribute((const void*)fwd_kernel<4>, hipFuncAttributeMaxDynamicSharedMemorySize, LDS_BYTES) == hipSuccess;
        okattr = okattr && hipFuncSetAttribute((const void*)fwd_kernel<5>, hipFuncAttributeMaxDynamicSharedMemorySize, LDS_BYTES) == hipSuccess;
        okattr = okattr && hipFuncSetAttribute((const void*)fwd_kernel<6>, hipFuncAttributeMaxDynamicSharedMemorySize, LDS_BYTES) == hipSuccess;
        okattr = okattr && hipFuncSetAttribute((const void*)fwd_kernel<7>, hipFuncAttributeMaxDynamicSharedMemorySize, LDS_BYTES) == hipSuccess;
        okattr = okattr && hipFuncSetAttribute((const void*)fwd_kernel<8>, hipFuncAttributeMaxDynamicSharedMemorySize, LDS_BYTES) == hipSuccess;
        okattr = okattr && hipFuncSetAttribute((const void*)fwd_kernel<9>, hipFuncAttributeMaxDynamicSharedMemorySize, LDS_BYTES) == hipSuccess;
        (void)per_cu;
#endif
        if (!okattr) { fprintf(stderr, "kernel_launch: hipFuncSetAttribute failed\n"); grid = -1; return; }
        (void)hipGetLastError();
        grid = cus;
    }
    if (grid < 0) return;
    (void)hipMemsetAsync((char*)d_ws + WS_CTL, 0, CTL_ZERO_BYTES, stream);
    Args a{};
    for (int i = 0; i < 21; ++i) a.in[i] = (const float*)d_in[i];
    a.out = (float*)d_out; a.ws = (unsigned char*)d_ws;
#if ONE_LAUNCH
    a.lo = 0; a.hi = N_STEPS;
    hipLaunchKernelGGL(fwd_kernel<-1>, dim3(grid), dim3(NWAVES * 64), LDS_BYTES, stream, a);
#else
    for (int s = 0; s < N_STEPS; ++s) { a.lo = s; a.hi = s + 1;
        switch (step_kind(s)) {
            case K_PREPA: hipLaunchKernelGGL(fwd_kernel<K_PREPA>, dim3(grid), dim3(NWAVES * 64), LDS_BYTES, stream, a); break;
            case K_PREPB: hipLaunchKernelGGL(fwd_kernel<K_PREPB>, dim3(grid), dim3(NWAVES * 64), LDS_BYTES, stream, a); break;
            case K_INAB: hipLaunchKernelGGL(fwd_kernel<K_INAB>, dim3(grid), dim3(NWAVES * 64), LDS_BYTES, stream, a); break;
            case K_ATT0: hipLaunchKernelGGL(fwd_kernel<K_ATT0>, dim3(grid), dim3(NWAVES * 64), LDS_BYTES, stream, a); break;
            case K_RES: hipLaunchKernelGGL(fwd_kernel<K_RES>, dim3(grid), dim3(NWAVES * 64), LDS_BYTES, stream, a); break;
            case K_UP: hipLaunchKernelGGL(fwd_kernel<K_UP>, dim3(grid), dim3(NWAVES * 64), LDS_BYTES, stream, a); break;
            case K_GATE: hipLaunchKernelGGL(fwd_kernel<K_GATE>, dim3(grid), dim3(NWAVES * 64), LDS_BYTES, stream, a); break;
            case K_INCD: hipLaunchKernelGGL(fwd_kernel<K_INCD>, dim3(grid), dim3(NWAVES * 64), LDS_BYTES, stream, a); break;
            case K_ATT1: hipLaunchKernelGGL(fwd_kernel<K_ATT1>, dim3(grid), dim3(NWAVES * 64), LDS_BYTES, stream, a); break;
            default: hipLaunchKernelGGL(fwd_kernel<K_FINAL>, dim3(grid), dim3(NWAVES * 64), LDS_BYTES, stream, a); break;
        }
    }
#endif
    const hipError_t le = hipPeekAtLastError();
    if (le != hipSuccess) fprintf(stderr, "kernel_launch: launch failed: %s\n", hipGetErrorName(le));
}
```
